# Optimizing an MI355X kernel written in HIP

```python
import math
import numpy as np
import jax
import jax.numpy as jnp
from jax import lax

D_MODEL = 1024
BATCH = 4
SEQ = 4096
DEPTH = 2

GRID_W = 64
CTX_LEN = 256
N_EVEN = (DEPTH + 1) // 2
N_ODD = DEPTH // 2
N_MOD = 6
NORM_EPS = 1e-6
ROPE_BASE = 10000.0

MLA_HEADS = 8
MLA_NOPE = 64
MLA_ROPE = 32
MLA_V = 64
Q_LORA = 384
KV_LORA = 256
MLA_Q_BLOCK = 128
MLA_SCALE = (MLA_NOPE + MLA_ROPE) ** -0.5

NA_HEADS = 8
NA_HEAD_DIM = 64
NA_WIN_H = 8
NA_WIN_W = 16
NA_SCALE = NA_HEAD_DIM ** -0.5

EVEN_IN = Q_LORA + KV_LORA + MLA_ROPE + 3 * NA_HEADS * NA_HEAD_DIM
EVEN_OUT = MLA_HEADS * MLA_V + NA_HEADS * NA_HEAD_DIM

S5_WIDTH = D_MODEL
S5_GROUP = 16
S5_GROUPS = S5_WIDTH // S5_GROUP
S5_STATE = 64

D_FF = 2816
N_EXPERTS = 8
TOP_K = 2
D_FF_EXPERT = 3584

kernel_name = 'hybrid_mla_natten_s5_moe_dit'


def rms_norm(x, g):
    xf = x.astype(jnp.float32)
    y = xf * lax.rsqrt(jnp.mean(xf * xf, axis=-1, keepdims=True) + NORM_EPS)
    return (y * g.astype(jnp.float32)).astype(x.dtype)


def modulate(x, g, shift, scale):
    return rms_norm(x, g) * (1 + scale) + shift


def adaln_params(cond, w, b):
    m = (jax.nn.silu(cond) @ w + b)[..., None, :]
    return jnp.split(m, N_MOD, axis=-1)


def softmax_f32(s):
    return jax.nn.softmax(s.astype(jnp.float32), axis=-1)


def dense_attend(s, v):
    p = softmax_f32(s).astype(v.dtype)
    return jnp.einsum('bhqk,bkhd->bqhd', p, v)


def axial_rope(x, row, col):
    half = x.shape[-1] // 2
    quarter = half // 2
    inv_freq = ROPE_BASE ** (-jnp.arange(quarter, dtype=jnp.float32) / quarter)
    bshape = (1, x.shape[1]) + (1,) * (x.ndim - 3) + (quarter,)

    def rotate(xa, pos):
        ang = pos.astype(jnp.float32)[:, None] * inv_freq[None, :]
        cos = jnp.cos(ang).reshape(bshape).astype(x.dtype)
        sin = jnp.sin(ang).reshape(bshape).astype(x.dtype)
        x1, x2 = xa[..., :quarter], xa[..., quarter:]
        return jnp.concatenate([x1 * cos - x2 * sin, x1 * sin + x2 * cos], axis=-1)

    return jnp.concatenate([rotate(x[..., :half], row), rotate(x[..., half:], col)], axis=-1)


def even_project(t, w_in, q_norm_g, w_qb, kv_norm_g, w_kvb):
    b, l, _ = t.shape
    p = t @ w_in
    cq, ckv, kr, qkv = jnp.split(p, [Q_LORA, Q_LORA + KV_LORA, Q_LORA + KV_LORA + MLA_ROPE], axis=-1)
    q = (rms_norm(cq, q_norm_g) @ w_qb).reshape(b, l, MLA_HEADS, MLA_NOPE + MLA_ROPE)
    kv = (rms_norm(ckv, kv_norm_g) @ w_kvb).reshape(b, l, MLA_HEADS, MLA_NOPE + MLA_V)
    qkv = qkv.reshape(b, l, 3, NA_HEADS, NA_HEAD_DIM)
    return (q[..., :MLA_NOPE], q[..., MLA_NOPE:], kv[..., :MLA_NOPE], kr, kv[..., MLA_NOPE:],
            qkv[:, :, 0], qkv[:, :, 1], qkv[:, :, 2])


def mla_scores(qn, qr, kn, kr):
    return (jnp.einsum('bqhd,bkhd->bhqk', qn, kn) + jnp.einsum('bqhr,bkr->bhqk', qr, kr)) * MLA_SCALE


def mla_latent(qn, qr, kn, kr, v, kn_c, kr_c, v_c):
    b, l, h, _ = qn.shape
    nb = l // MLA_Q_BLOCK

    def to_blocks(t):
        return t.reshape((b, nb, MLA_Q_BLOCK) + t.shape[2:]).swapaxes(0, 1)

    def block(qs):
        qn_b, qr_b = qs
        s = jnp.concatenate([mla_scores(qn_b, qr_b, kn, kr), mla_scores(qn_b, qr_b, kn_c, kr_c)], axis=-1)
        p = softmax_f32(s).astype(v.dtype)
        return (jnp.einsum('bhqk,bkhd->bqhd', p[..., :l], v)
                + jnp.einsum('bhqk,bkhd->bqhd', p[..., l:], v_c))

    out = lax.map(block, (to_blocks(qn), to_blocks(qr)))
    return out.swapaxes(0, 1).reshape(b, l, h * MLA_V)


def na_latent(q, k, v, k_c, v_c, rpb):
    b, l, h, d = q.shape
    rows = l // GRID_W
    kh = min(NA_WIN_H, rows)
    r = np.arange(rows)
    row_start = np.clip(r - kh // 2, 0, rows - kh)
    row_off = row_start[:, None] + np.arange(kh)[None, :] - r[:, None] + (NA_WIN_H - 1)
    cidx = np.arange(GRID_W)
    col_start = np.clip(cidx - NA_WIN_W // 2, 0, GRID_W - NA_WIN_W)
    col_idx = col_start[:, None] + np.arange(NA_WIN_W)[None, :]
    col_off = col_idx - cidx[:, None] + (NA_WIN_W - 1)
    bias = rpb[:, row_off][..., col_off].transpose(1, 0, 3, 2, 4)
    n_win = kh * NA_WIN_W
    qg = (q * NA_SCALE).reshape(b, rows, GRID_W, h, d).swapaxes(0, 1)
    kg = k.reshape(b, rows, GRID_W, h, d)
    vg = v.reshape(b, rows, GRID_W, h, d)

    def row_block(xs):
        q_r, start, bias_r = xs
        k_win = lax.dynamic_slice_in_dim(kg, start, kh, axis=1)[:, :, col_idx]
        v_win = lax.dynamic_slice_in_dim(vg, start, kh, axis=1)[:, :, col_idx]
        s_win = jnp.einsum('bqhd,biqjhd->bhqij', q_r, k_win) + bias_r
        s_ctx = jnp.einsum('bqhd,bkhd->bhqk', q_r, k_c)
        s = jnp.concatenate([s_win.reshape(b, h, GRID_W, n_win), s_ctx], axis=-1)
        p = softmax_f32(s).astype(v.dtype)
        p_win = p[..., :n_win].reshape(b, h, GRID_W, kh, NA_WIN_W)
        return (jnp.einsum('bhqij,biqjhd->bqhd', p_win, v_win)
                + jnp.einsum('bhqk,bkhd->bqhd', p[..., n_win:], v_c))

    out = lax.map(row_block, (qg, jnp.asarray(row_start, jnp.int32), bias))
    return out.swapaxes(0, 1).reshape(b, l, h * d)


def even_mixer(h, hc, w_in, q_norm_g, w_qb, kv_norm_g, w_kvb, rpb, w_out, need_ctx):
    b, l, _ = h.shape
    qn, qr, kn, kr, v, nq, nk, nv = even_project(h, w_in, q_norm_g, w_qb, kv_norm_g, w_kvb)
    qn_c, qr_c, kn_c, kr_c, v_c, nq_c, nk_c, nv_c = even_project(hc, w_in, q_norm_g, w_qb, kv_norm_g, w_kvb)
    t = jnp.arange(l)
    row, col = t // GRID_W, t % GRID_W
    qr = axial_rope(qr, row, col)
    kr = axial_rope(kr, row, col)
    mla = mla_latent(qn, qr, kn, kr, v, kn_c, kr_c, v_c)
    na = na_latent(nq, nk, nv, nk_c, nv_c, rpb)
    y = jnp.concatenate([mla, na], axis=-1) @ w_out
    if not need_ctx:
        return y, None
    lc = hc.shape[1]
    mla_c = dense_attend(mla_scores(qn_c, qr_c, kn_c, kr_c), v_c).reshape(b, lc, MLA_HEADS * MLA_V)
    na_c = dense_attend(jnp.einsum('bqhd,bkhd->bhqk', nq_c * NA_SCALE, nk_c), nv_c).reshape(b, lc, NA_HEADS * NA_HEAD_DIM)
    yc = jnp.concatenate([mla_c, na_c], axis=-1) @ w_out
    return y, yc


def s5_discretize(a_re, a_im, log_step, b_re, b_im):
    dt = jnp.exp(log_step)[:, None]
    decay = jnp.exp(a_re * dt)
    ab_re = decay * jnp.cos(a_im * dt)
    ab_im = decay * jnp.sin(a_im * dt)
    den = a_re * a_re + a_im * a_im
    f_re = ((ab_re - 1) * a_re + ab_im * a_im) / den
    f_im = (ab_im * a_re - (ab_re - 1) * a_im) / den
    bb_re = f_re[..., None] * b_re - f_im[..., None] * b_im
    bb_im = f_re[..., None] * b_im + f_im[..., None] * b_re
    return ab_re, ab_im, bb_re, bb_im


def linear_recurrence(e1, e2):
    a1r, a1i, b1r, b1i = e1
    a2r, a2i, b2r, b2i = e2
    return (a2r * a1r - a2i * a1i, a2r * a1i + a2i * a1r,
            a2r * b1r - a2i * b1i + b2r, a2r * b1i + a2i * b1r + b2i)


def ssm_scan(bu_re, bu_im, ab_re, ab_im, h0, reverse):
    if reverse:
        bu_re, bu_im = jnp.flip(bu_re, axis=1), jnp.flip(bu_im, axis=1)
    if h0 is not None:
        h0r, h0i = h0
        bu_re = bu_re.at[:, 0].add(ab_re * h0r - ab_im * h0i)
        bu_im = bu_im.at[:, 0].add(ab_re * h0i + ab_im * h0r)
    l = bu_re.shape[1]
    a_re = jnp.broadcast_to(ab_re, (1, l) + ab_re.shape)
    a_im = jnp.broadcast_to(ab_im, (1, l) + ab_im.shape)
    _, _, hr, hi = lax.associative_scan(linear_recurrence, (a_re, a_im, bu_re, bu_im), axis=1)
    if reverse:
        hr, hi = jnp.flip(hr, axis=1), jnp.flip(hi, axis=1)
    return hr, hi


def glu(t, w_glu):
    z = t @ w_glu
    return z[..., :D_MODEL] * jax.nn.sigmoid(z[..., D_MODEL:])


def s5_mixer(h, hc, w_in, a_re, a_im, log_step, b_re, b_im, c_re, c_im, d_skip, w_glu, need_ctx):
    b, l, _ = h.shape
    lc = hc.shape[1]
    u = h @ w_in
    u_c = hc @ w_in
    ug = u.reshape(b, l, S5_GROUPS, S5_GROUP)
    ug_c = u_c.reshape(b, lc, S5_GROUPS, S5_GROUP)
    y = u * d_skip
    y_c = u_c * d_skip if need_ctx else None
    for direction in range(2):
        reverse = direction == 1
        ab_re, ab_im, bb_re, bb_im = s5_discretize(a_re[direction], a_im[direction], log_step[direction],
                                                   b_re[direction], b_im[direction])
        cr, ci = c_re[direction], c_im[direction]

        def drive(t):
            return (jnp.einsum('blgi,gpi->blgp', t, bb_re), jnp.einsum('blgi,gpi->blgp', t, bb_im))

        def readout(hr, hi):
            out = jnp.einsum('blgp,gip->blgi', hr, cr) - jnp.einsum('blgp,gip->blgi', hi, ci)
            return out.reshape(hr.shape[0], hr.shape[1], S5_WIDTH)

        hc_re, hc_im = ssm_scan(*drive(ug_c), ab_re, ab_im, None, reverse)
        end = 0 if reverse else -1
        h_re, h_im = ssm_scan(*drive(ug), ab_re, ab_im, (hc_re[:, end], hc_im[:, end]), reverse)
        y = y + readout(h_re, h_im)
        if need_ctx:
            y_c = y_c + readout(hc_re, hc_im)
    out = glu(jax.nn.gelu(y), w_glu)
    out_c = glu(jax.nn.gelu(y_c), w_glu) if need_ctx else None
    return out, out_c


def swiglu(t, w_gate, w_up, w_down):
    return (jax.nn.silu(t @ w_gate) * (t @ w_up)) @ w_down


def moe_swiglu(t, w_router, w_gate, w_up, w_down):
    logits = (t @ w_router).astype(jnp.float32)
    top_val, top_idx = lax.top_k(logits, TOP_K)
    top_w = jax.nn.softmax(top_val, axis=-1)
    comb = jnp.sum(jax.nn.one_hot(top_idx, N_EXPERTS, dtype=jnp.float32) * top_w[..., None], axis=-2).astype(t.dtype)
    out = comb[..., 0:1] * swiglu(t, w_gate[0], w_up[0], w_down[0])
    for e in range(1, N_EXPERTS):
        out = out + comb[..., e:e + 1] * swiglu(t, w_gate[e], w_up[e], w_down[e])
    return out


def setup_inputs(seed: int = 0) -> dict:
    key = jax.random.key(seed)
    ks = iter(jax.random.split(key, 48))
    D = D_MODEL

    def nrm(shape, scale):
        return scale * jax.random.normal(next(ks), shape, jnp.float32)

    def gain(shape):
        return 1.0 + nrm(shape, 0.05)

    inp = {}
    inp['x'] = nrm((BATCH, SEQ, D), 1.0)
    inp['c'] = nrm((BATCH, D), 1.0)
    inp['ctx'] = nrm((BATCH, CTX_LEN, D), 1.0)
    inp['c_ctx'] = nrm((D,), 1.0)
    inp['mod_w'] = nrm((DEPTH, D, N_MOD * D), 0.5 * D ** -0.5)
    inp['mod_b'] = nrm((DEPTH, N_MOD * D), 0.02)
    inp['norm1_g'] = gain((DEPTH, D))
    inp['norm2_g'] = gain((DEPTH, D))
    inp['ev_w_in'] = nrm((N_EVEN, D, EVEN_IN), D ** -0.5)
    inp['ev_q_norm_g'] = gain((N_EVEN, Q_LORA))
    inp['ev_w_qb'] = nrm((N_EVEN, Q_LORA, MLA_HEADS * (MLA_NOPE + MLA_ROPE)), Q_LORA ** -0.5)
    inp['ev_kv_norm_g'] = gain((N_EVEN, KV_LORA))
    inp['ev_w_kvb'] = nrm((N_EVEN, KV_LORA, MLA_HEADS * (MLA_NOPE + MLA_V)), KV_LORA ** -0.5)
    inp['ev_na_rpb'] = nrm((N_EVEN, NA_HEADS, 2 * NA_WIN_H - 1, 2 * NA_WIN_W - 1), 0.2)
    inp['ev_w_out'] = nrm((N_EVEN, EVEN_OUT, D), EVEN_OUT ** -0.5)
    inp['ev_ffn_w_gate'] = nrm((N_EVEN, D, D_FF), D ** -0.5)
    inp['ev_ffn_w_up'] = nrm((N_EVEN, D, D_FF), D ** -0.5)
    inp['ev_ffn_w_down'] = nrm((N_EVEN, D_FF, D), D_FF ** -0.5)
    inp['od_w_in'] = nrm((N_ODD, D, S5_WIDTH), D ** -0.5)
    inp['od_a_re'] = -0.5 + nrm((N_ODD, 2, S5_GROUPS, S5_STATE), 0.01)
    inp['od_a_im'] = math.pi * jnp.arange(S5_STATE, dtype=jnp.float32) + nrm((N_ODD, 2, S5_GROUPS, S5_STATE), 0.01)
    inp['od_log_step'] = jax.random.uniform(next(ks), (N_ODD, 2, S5_GROUPS), jnp.float32,
                                            math.log(1e-3), math.log(1e-1))
    inp['od_b_re'] = nrm((N_ODD, 2, S5_GROUPS, S5_STATE, S5_GROUP), (2 * S5_GROUP) ** -0.5)
    inp['od_b_im'] = nrm((N_ODD, 2, S5_GROUPS, S5_STATE, S5_GROUP), (2 * S5_GROUP) ** -0.5)
    inp['od_c_re'] = nrm((N_ODD, 2, S5_GROUPS, S5_GROUP, S5_STATE), S5_STATE ** -0.5)
    inp['od_c_im'] = nrm((N_ODD, 2, S5_GROUPS, S5_GROUP, S5_STATE), S5_STATE ** -0.5)
    inp['od_d'] = nrm((N_ODD, S5_WIDTH), 1.0)
    inp['od_w_glu'] = nrm((N_ODD, S5_WIDTH, 2 * D), S5_WIDTH ** -0.5)
    inp['moe_w_router'] = nrm((N_ODD, D, N_EXPERTS), D ** -0.5)
    inp['moe_w_gate'] = nrm((N_ODD, N_EXPERTS, D, D_FF_EXPERT), D ** -0.5)
    inp['moe_w_up'] = nrm((N_ODD, N_EXPERTS, D, D_FF_EXPERT), D ** -0.5)
    inp['moe_w_down'] = nrm((N_ODD, N_EXPERTS, D_FF_EXPERT, D), D_FF_EXPERT ** -0.5)
    inp['final_g'] = gain((D,))
    return inp


def reference(x, c, ctx, c_ctx, mod_w, mod_b, norm1_g, norm2_g,
              ev_w_in, ev_q_norm_g, ev_w_qb, ev_kv_norm_g, ev_w_kvb, ev_na_rpb, ev_w_out,
              ev_ffn_w_gate, ev_ffn_w_up, ev_ffn_w_down,
              od_w_in, od_a_re, od_a_im, od_log_step, od_b_re, od_b_im, od_c_re, od_c_im, od_d, od_w_glu,
              moe_w_router, moe_w_gate, moe_w_up, moe_w_down, final_g):
    xc = ctx
    for layer in range(DEPTH):
        last = layer == DEPTH - 1
        i = layer // 2
        sh1, sc1, g1, sh2, sc2, g2 = adaln_params(c, mod_w[layer], mod_b[layer])
        sh1c, sc1c, g1c, sh2c, sc2c, g2c = adaln_params(c_ctx, mod_w[layer], mod_b[layer])
        h = modulate(x, norm1_g[layer], sh1, sc1)
        hc = modulate(xc, norm1_g[layer], sh1c, sc1c)
        if layer % 2 == 0:
            y, yc = even_mixer(h, hc, ev_w_in[i], ev_q_norm_g[i], ev_w_qb[i], ev_kv_norm_g[i],
                               ev_w_kvb[i], ev_na_rpb[i], ev_w_out[i], not last)

            def channel_mix(t):
                return swiglu(t, ev_ffn_w_gate[i], ev_ffn_w_up[i], ev_ffn_w_down[i])
        else:
            y, yc = s5_mixer(h, hc, od_w_in[i], od_a_re[i], od_a_im[i], od_log_step[i], od_b_re[i],
                             od_b_im[i], od_c_re[i], od_c_im[i], od_d[i], od_w_glu[i], not last)

            def channel_mix(t):
                return moe_swiglu(t, moe_w_router[i], moe_w_gate[i], moe_w_up[i], moe_w_down[i])
        x = x + g1 * y
        x = x + g2 * channel_mix(modulate(x, norm2_g[layer], sh2, sc2))
        if not last:
            xc = xc + g1c * yc
            xc = xc + g2c * channel_mix(modulate(xc, norm2_g[layer], sh2c, sc2c))
    return rms_norm(x, final_g)
```

```cpp
#define DBG_MODE 0
#define PER_PHASE 0
#include <hip/hip_runtime.h>
#include <cstdio>
#include <cstdint>
#define LAS __attribute__((address_space(3)))
#define GAS __attribute__((address_space(1)))
typedef unsigned short bf16_t;
typedef short bf16x8 __attribute__((ext_vector_type(8)));
typedef short s16x4 __attribute__((ext_vector_type(4)));
typedef float f32x4 __attribute__((ext_vector_type(4)));
typedef float f32x16 __attribute__((ext_vector_type(16)));
typedef unsigned u32x4 __attribute__((ext_vector_type(4)));
typedef unsigned u32x2 __attribute__((ext_vector_type(2)));
typedef float f32x2 __attribute__((ext_vector_type(2)));

__device__ __forceinline__ unsigned f2bf(float f) { unsigned u = __builtin_bit_cast(unsigned, f); return (u + 0x7fffu + ((u >> 16) & 1u)) >> 16; }
__device__ __forceinline__ unsigned pk2(float lo, float hi) { return f2bf(lo) | (f2bf(hi) << 16); }
__device__ __forceinline__ unsigned cvt_pk_bf16(float lo, float hi) { unsigned r; asm volatile("v_cvt_pk_bf16_f32 %0, %1, %2" : "=v"(r) : "v"(lo), "v"(hi)); return r; }
__device__ __forceinline__ float bf_lo(unsigned w) { return __builtin_bit_cast(float, w << 16); }
__device__ __forceinline__ float bf_hi(unsigned w) { return __builtin_bit_cast(float, w & 0xffff0000u); }
__device__ __forceinline__ float wave_sum(float v) {
#pragma unroll
    for (int o = 1; o < 64; o <<= 1) v += __shfl_xor(v, o);
    return v;
}
__device__ __forceinline__ float fast_sigmoid(float x) { return __builtin_amdgcn_rcpf(1.f + __builtin_amdgcn_exp2f(-1.4426950408889634f * x)); }

namespace pg8 {
constexpr int BM = 256, BK = 64, HALF = 128, HTB = HALF * BK * 2  , STAGE_BYTES = 8 * HTB, NXCD = 8, WGM = 8;
__host__ __device__ __forceinline__ int lds_byte(int r, int c) { const int st = (r >> 4) * 2 + (c >> 5), rr = r & 15, cc = c & 31, ob = rr * 64 + cc * 2; return st * 1024 + (ob ^ (((ob >> 9) & 1) << 5)); }
__host__ __device__ __forceinline__ void stage_rc(int b, int& R, int& C) { const int st = b / 1024, sb = b % 1024, swz = sb ^ (((sb >> 9) & 1) << 5); R = (st >> 1) * 16 + swz / 64; C = (st & 1) * 32 + (swz % 64) / 2; }
__host__ __device__ __forceinline__ int perm32(int rho) { const int n = rho >> 4, i = rho & 15; return 8 * (i >> 2) + 4 * n + (i & 3); }

struct Unit { int pm, pn, ks; };
struct Order {
    int nM, nN, nwg, G, c, rep;
    __device__ __forceinline__ void init(int nM_, int nN_, int G_, int c_, int rep_ = 1) { nM = nM_; nN = nN_; nwg = nM * nN; G = G_; c = c_; rep = rep_; }
    __device__ __forceinline__ bool next(int i, Unit& u) const {
        long L = (long)i * G + c; if (L >= (long)nwg * rep) return false; L %= nwg; map((int)L, u); return true; }
    __device__ __forceinline__ void map(int L, Unit& u) const {
        int wgid = L; u.ks = -1; { const int q = nwg / NXCD, r = nwg % NXCD, xcd = wgid % NXCD, off = wgid / NXCD; wgid = (xcd < r ? xcd * (q + 1) : r * (q + 1) + (xcd - r) * q) + off; }
        const int nig = WGM * nN, gid = wgid / nig, fm = gid * WGM, gsz = (nM - fm) < WGM ? (nM - fm) : WGM;
        u.pm = fm + ((wgid % nig) % gsz); u.pn = (wgid % nig) / gsz;
    }
};

template <class Epi, class Sched, bool ALIGN_EPI = true>
__device__ __forceinline__ void gemm_phase(LAS unsigned char* lds, const int K, const int lda, const int ldb, const Sched& S, const Epi& E) {
    const int tid = threadIdx.x, wid = __builtin_amdgcn_readfirstlane(tid >> 6), lane = tid & 63, wr = wid >> 2, wc = wid & 3, fr = lane & 15, fq = lane >> 4;
    unsigned voffA[2], voffB[2];
#pragma unroll
    for (int i = 0; i < 2; ++i) { int R, C; stage_rc(tid * 16 + i * 8192, R, C); const int Rb = (R & ~31) + perm32(R & 31);
        voffA[i] = (unsigned)(R * lda + C) * 2u; voffB[i] = (unsigned)(Rb * ldb + C) * 2u; }
    const size_t kstep = (size_t)(BK * 2);
    const size_t hstepA = (size_t)HALF * lda * 2, hstepB = (size_t)HALF * ldb * 2;
    const unsigned ldsw = (unsigned)wid * 1024u;
    const int aoff = lds_byte(wr * 64 + fr, fq * 8), boff = lds_byte(wc * 32 + fr, fq * 8);
#define PG8_SA(b, h) (((b) * 2 + (h)) * HTB)
#define PG8_SB(b, h) ((4 + (b) * 2 + (h)) * HTB)
#define PG8_STAGE(bufoff, gbase, voff) do { _Pragma("unroll") for (int _i = 0; _i < 2; ++_i) \
        __builtin_amdgcn_global_load_lds((const unsigned*)((const char*)(gbase) + (voff)[_i]), (LAS unsigned*)(lds + (bufoff) + ldsw + _i * 8192), 16, 0, 0); } while (0)
#define PG8_LDA(dst, b, h) do { _Pragma("unroll") for (int m = 0; m < 4; ++m) _Pragma("unroll") for (int k = 0; k < 2; ++k) dst[m][k] = *(const LAS bf16x8*)(lds + PG8_SA(b, h) + aoff + m * 2048 + k * 1024); } while (0)
#define PG8_LDB(dst, b, h) do { _Pragma("unroll") for (int n = 0; n < 2; ++n) _Pragma("unroll") for (int k = 0; k < 2; ++k) dst[n][k] = *(const LAS bf16x8*)(lds + PG8_SB(b, h) + boff + n * 2048 + k * 1024); } while (0)
#define PG8_MMA(ai, bj, At, Bt) do { __builtin_amdgcn_s_setprio(1); _Pragma("unroll") for (int m = 0; m < 4; ++m) _Pragma("unroll") for (int n = 0; n < 2; ++n) _Pragma("unroll") for (int k = 0; k < 2; ++k) \
        acc[ai][bj][m][n] = __builtin_amdgcn_mfma_f32_16x16x32_bf16(Bt[n][k], At[m][k], acc[ai][bj][m][n], 0, 0, 0); __builtin_amdgcn_s_setprio(0); } while (0)
#define PG8_WAIT_V(n) asm volatile("s_waitcnt vmcnt(" #n ")" ::: "memory")
#define PG8_WAIT_L(n) asm volatile("s_waitcnt lgkmcnt(" #n ")" ::: "memory")
#define PG8_BAR __builtin_amdgcn_s_barrier()
#define PG8_SCHED __builtin_amdgcn_sched_barrier(0)
    Unit cur, nxt; int ui = 0;
    if (!S.next(0, cur)) return;
    f32x4 acc[2][2][4][2];
#pragma unroll
    for (int a = 0; a < 2; ++a)
#pragma unroll
        for (int b = 0; b < 2; ++b)
#pragma unroll
            for (int m = 0; m < 4; ++m)
#pragma unroll
                for (int n = 0; n < 2; ++n) acc[a][b][m][n] = (f32x4){0.f, 0.f, 0.f, 0.f};
    bf16x8 At[4][2], B0[2][2], B1[2][2];
    const char* cA = S.aptr(cur); const char* cB = S.bptr(cur); int nt = S.ktiles(cur); (void)K;
    PG8_STAGE(PG8_SB(0, 0), cB, voffB); PG8_STAGE(PG8_SB(0, 1), cB + hstepB, voffB); PG8_STAGE(PG8_SA(0, 0), cA, voffA); PG8_STAGE(PG8_SA(0, 1), cA + hstepA, voffA);
    if (wr == 1) PG8_BAR;
    PG8_WAIT_V(2); PG8_BAR;
    PG8_STAGE(PG8_SB(1, 0), cB + kstep, voffB); PG8_STAGE(PG8_SA(1, 0), cA + kstep, voffA); PG8_STAGE(PG8_SB(1, 1), cB + hstepB + kstep, voffB);
    PG8_WAIT_V(6); PG8_BAR;
    for (;;) {
        const bool has_next = S.next(ui + 1, nxt);
        const char* nA = has_next ? S.aptr(nxt) : cA; const char* nB = has_next ? S.bptr(nxt) : cB;
#pragma unroll 1
        for (int t = 0; t < nt; t += 2) {
            const bool last = (t == nt - 2);
            const char* a1 = cA + (size_t)(t + 1) * kstep;
            const char* a2 = last ? nA : cA + (size_t)(t + 2) * kstep; const char* b2 = last ? nB : cB + (size_t)(t + 2) * kstep;
            const char* a3 = a2 + kstep; const char* b3 = b2 + kstep;
            PG8_LDB(B0, 0, 0); PG8_LDB(B1, 0, 1); PG8_SCHED; PG8_LDA(At, 0, 0); PG8_STAGE(PG8_SA(1, 1), a1 + hstepA, voffA);
            PG8_WAIT_V(8); PG8_WAIT_L(0); PG8_BAR; PG8_MMA(0, 0, At, B0); PG8_MMA(0, 1, At, B1); PG8_BAR; PG8_SCHED;
            PG8_LDA(At, 0, 1); PG8_STAGE(PG8_SB(0, 0), b2, voffB); PG8_STAGE(PG8_SB(0, 1), b2 + hstepB, voffB); PG8_STAGE(PG8_SA(0, 0), a2, voffA);
            PG8_WAIT_V(8); PG8_WAIT_L(0); PG8_BAR; PG8_MMA(1, 0, At, B0); PG8_MMA(1, 1, At, B1); PG8_BAR; PG8_SCHED;
            PG8_LDB(B0, 1, 0); PG8_LDB(B1, 1, 1); PG8_SCHED; PG8_LDA(At, 1, 0); PG8_STAGE(PG8_SA(0, 1), a2 + hstepA, voffA);
            PG8_WAIT_V(8); PG8_WAIT_L(0); PG8_BAR; PG8_MMA(0, 0, At, B0); PG8_MMA(0, 1, At, B1); PG8_BAR; PG8_SCHED;
            PG8_LDA(At, 1, 1); PG8_STAGE(PG8_SB(1, 0), b3, voffB); PG8_STAGE(PG8_SB(1, 1), b3 + hstepB, voffB); PG8_STAGE(PG8_SA(1, 0), a3, voffA);
            PG8_WAIT_V(8); PG8_WAIT_L(0); PG8_BAR; PG8_MMA(1, 0, At, B0); PG8_MMA(1, 1, At, B1); PG8_BAR; PG8_SCHED;
        }
        if constexpr (ALIGN_EPI) { if (wr == 0) PG8_BAR; }
        E(acc, cur, wr, wc, fr, fq);
        if (!has_next) break;
#pragma unroll
        for (int a = 0; a < 2; ++a)
#pragma unroll
            for (int b = 0; b < 2; ++b)
#pragma unroll
                for (int m = 0; m < 4; ++m)
#pragma unroll
                    for (int n = 0; n < 2; ++n) acc[a][b][m][n] = (f32x4){0.f, 0.f, 0.f, 0.f};
        cur = nxt; cA = nA; cB = nB; ++ui; nt = S.ktiles(cur);
        if constexpr (ALIGN_EPI) { if (wr == 1) PG8_BAR; }
    }
    PG8_WAIT_V(0);
    if constexpr (!ALIGN_EPI) { if (wr == 0) PG8_BAR; }
    PG8_BAR;
#undef PG8_SA
#undef PG8_SB
#undef PG8_STAGE
#undef PG8_LDA
#undef PG8_LDB
#undef PG8_MMA
#undef PG8_WAIT_V
#undef PG8_WAIT_L
#undef PG8_BAR
#undef PG8_SCHED
}
}

#define XB_TMO      128
#define XB_XCNT(j)  (256  + 64 * (j))
#define XB_XSUB(j)  (1280 + 64 * (j))
#define XB_XGEN(j)  (2304 + 64 * (j))
#define XB_TOP      3328
#define XB_TOPGEN   3392
#define XCD_BAR_WORDS 3456
#define XB_SPIN_CAP (1u << 18)
__device__ __forceinline__ unsigned xb_ld(unsigned* p)              { return __hip_atomic_load(p, __ATOMIC_RELAXED, __HIP_MEMORY_SCOPE_AGENT); }
__device__ __forceinline__ unsigned xb_add(unsigned* p, unsigned v) { return __hip_atomic_fetch_add(p, v, __ATOMIC_RELAXED, __HIP_MEMORY_SCOPE_AGENT); }
__device__ __forceinline__ unsigned xb_xcc_id() { return (unsigned)__builtin_amdgcn_s_getreg((3 << 11) | 20) & 0xFu; }
#define XB_SPIN(cond, bar) do { unsigned _sp = 0; while (cond) { __builtin_amdgcn_s_sleep(1); \
    if ((++_sp & 255u) == 0u) { if (xb_ld(&(bar)[XB_TMO])) break; if (_sp > XB_SPIN_CAP) { atomicAdd(&(bar)[XB_TMO], 1u); break; } } } } while (0)
struct XcdBarrier { unsigned* bar; unsigned x; volatile LAS unsigned* st; };
__device__ __forceinline__ XcdBarrier xcd_barrier_post(unsigned* bar, volatile LAS unsigned* st) {
    XcdBarrier b; b.bar = bar; b.x = xb_xcc_id(); b.st = st;
    if (threadIdx.x == 0) (void)xb_add(&bar[XB_XCNT(b.x)], 1u);
    return b;
}
__device__ __forceinline__ void xcd_barrier_complete(unsigned* bar, unsigned x, unsigned& nloc, unsigned& nx) {
    const unsigned G = gridDim.x * gridDim.y * gridDim.z;
    unsigned sum, cnt, mine, sp = 0u;
    for (;;) {
        sum = 0u; cnt = 0u; mine = 0u;
#pragma unroll
        for (unsigned j = 0; j < 16; ++j) { const unsigned c = xb_ld(&bar[XB_XCNT(j)]); sum += c; cnt += (c > 0u) ? 1u : 0u; mine = (j == x) ? c : mine; }
        if (sum == G) break;
        __builtin_amdgcn_s_sleep(1);
        if ((++sp & 255u) == 0u) { if (xb_ld(&bar[XB_TMO])) break; if (sp > XB_SPIN_CAP) { atomicAdd(&bar[XB_TMO], 1u); break; } }
    }
    nloc = mine > 0u ? mine : 1u; nx = cnt > 0u ? cnt : 1u;
}
__device__ __forceinline__ void xcd_barrier(const XcdBarrier& b) {
    asm volatile("s_waitcnt vmcnt(0)" ::: "memory");
    __syncthreads();
    if (threadIdx.x == 0) {
        unsigned* bar = b.bar;
        __builtin_amdgcn_s_waitcnt(0);
        unsigned nloc = b.st[0], nx = b.st[1];
        if (nloc == 0u) { xcd_barrier_complete(bar, b.x, nloc, nx); b.st[0] = nloc; b.st[1] = nx; }
        const unsigned old = xb_add(&bar[XB_XSUB(b.x)], 1u);
        const unsigned gen = old / nloc;
        if (old + 1u == (gen + 1u) * nloc) {
            __builtin_amdgcn_fence(__ATOMIC_RELEASE, "agent");
            asm volatile("s_waitcnt vmcnt(0)" ::: "memory");
            const unsigned og = xb_add(&bar[XB_TOP], 1u);
            const unsigned tg = og / nx;
            if (og + 1u == (tg + 1u) * nx) xb_add(&bar[XB_TOPGEN], 1u);
            else XB_SPIN(xb_ld(&bar[XB_TOPGEN]) == tg, bar);
            __builtin_amdgcn_fence(__ATOMIC_ACQUIRE, "agent");
            xb_add(&bar[XB_XGEN(b.x)], 1u);
            asm volatile("s_waitcnt vmcnt(0)" ::: "memory");
        } else {
            XB_SPIN(xb_ld(&bar[XB_XGEN(b.x)]) == gen, bar);
            __builtin_amdgcn_fence(__ATOMIC_ACQUIRE, "agent");
            asm volatile("s_waitcnt vmcnt(0)" ::: "memory");
        }
    }
    __syncthreads();
}
namespace fp {
constexpr int D = 1024, NB = 4, SEQ = 4096, CTX = 256, ML = NB * SEQ, MC = NB * CTX, MT = ML + MC;
constexpr int NIN = 2304;
constexpr int DFF = 2816, DFE = 3584, NE = 8;
#ifndef DFFP
#define DFFP 2816
#endif
constexpr int LDF = DFFP;
constexpr int NWAVES = 8, NTHR = 512;
constexpr float LOG2E = 1.4426950408889634f;
constexpr float C2_MLA = 0.10206207261596577f * LOG2E;
constexpr float C2_NA = 0.125f * LOG2E;
constexpr float EPS = 1e-6f;
constexpr int TCH = 32, NCH = SEQ / TCH  , NCHC = CTX / TCH  , SK = TCH * 16  , SKA = SK + 256  ;

constexpr size_t MiB = 1u << 20;
constexpr size_t WS_CTL = 0, CTL_BYTES = 1 * MiB;
constexpr size_t WS_SSQ = 10 * MiB;
constexpr size_t CTL_CNT = 256 * 1024;
constexpr size_t CTL_DONE = 280 * 1024;
constexpr size_t CTL_ADALN = 290 * 1024;
constexpr size_t CTL_Q0 = 300 * 1024;
constexpr size_t WS_MODP = 1 * MiB;
constexpr size_t WS_TOK = WS_MODP + 256 * 1024;
constexpr size_t WS_XC = 2 * MiB;
constexpr size_t WS_KKER = 6 * MiB;
constexpr size_t WS_WMOE_GU = 12 * MiB;
constexpr size_t WS_WMOE_D = WS_WMOE_GU + 112 * MiB;
constexpr size_t WS_C = 180 * MiB;
constexpr size_t WS_WIN0 = WS_C;
constexpr size_t WS_WQB = WS_WIN0 + (size_t)NIN * D * 2;
constexpr size_t WS_WKVB = WS_WQB + 768 * 384 * 2;
constexpr size_t WS_WOUT = WS_WKVB + 1024 * 256 * 2;
constexpr size_t WS_WFGU = WS_WOUT + 1024 * 1024 * 2;
constexpr size_t WS_WFD = WS_WFGU + (size_t)5632 * 1024 * 2;
constexpr size_t WS_WS5 = WS_WFD + (size_t)1024 * LDF * 2;
constexpr size_t WS_WGLU = WS_WS5 + 1024 * 1024 * 2;
constexpr size_t WS_BHAT = WS_WGLU + 2048 * 1024 * 2;
constexpr size_t WS_LT = WS_BHAT + (size_t)64 * 256 * SK * 2;
constexpr size_t WS_WEND = WS_LT + (size_t)64 * 512 * SKA * 2;
static_assert(WS_WEND <= 275 * MiB, "non-moe weights region");
constexpr size_t WS_ACT = 275 * MiB;
constexpr size_t WS_HB = 479 * MiB;
constexpr size_t WS_END = WS_HB + (size_t)MT * D * 2;
static_assert(WS_END <= 513 * MiB, "ws end");
constexpr size_t WS_P = WS_ACT;
constexpr size_t WS_Q = WS_P + (size_t)MT * NIN * 2;
constexpr size_t WS_KF = WS_Q + (size_t)MT * 768 * 2;
constexpr size_t WS_V = WS_KF + (size_t)MT * 768 * 2;
constexpr size_t WS_AO = WS_V + (size_t)MT * 512 * 2;
static_assert(WS_AO + (size_t)MT * D * 2 <= WS_HB, "L0 mixer activations");
constexpr size_t WS_HF = WS_ACT;
static_assert(WS_HF + (size_t)MT * LDF * 2 <= WS_AO, "HF must not overlay AO (w_out reads AO before HF is written? no: separate phases, but keep clear)");
constexpr size_t WS_ACAT = WS_ACT;
constexpr size_t WS_ACATC = WS_ACAT + (size_t)64 * 512 * SKA * 2;
constexpr size_t WS_SLOC = WS_ACATC + (size_t)(64 * 32 + 256) * SKA * 2;
constexpr size_t WS_GB = WS_SLOC + (size_t)64 * 544 * 256 * 4;
static_assert(WS_GB + (size_t)ML * D * 2 <= WS_HB, "L1 mixer activations");
constexpr size_t WS_Y1 = WS_ACT;
constexpr size_t WS_Y2 = WS_AO;
constexpr size_t WS_Y3 = 400 * MiB;
static_assert(WS_GB + (size_t)ML * D * 2 <= WS_Y3 && WS_Y3 + (size_t)ML * D * 2 <= WS_HB, "Y3 placement");
constexpr size_t WS_PART5 = 320 * MiB;
constexpr size_t WS_PART8 = 372 * MiB;
static_assert(WS_PART8 + (size_t)11 * MC * D * 4 <= WS_Y2 && WS_HF + (size_t)MT * LDF * 2 <= WS_PART8, "PART8 placement");
constexpr size_t WS_PART18 = WS_WMOE_GU;
constexpr int MOE_ROWS = 2 * ML + NE * 256;
constexpr size_t WS_XG = WS_C;
constexpr size_t WS_HM = WS_XG + (size_t)MOE_ROWS * D * 2;
static_assert(WS_HM + (size_t)MOE_ROWS * DFE * 2 <= 513 * MiB, "moe hidden");

constexpr int RING_BYTES = 131072;
constexpr int LDS_ROPE = RING_BYTES;
constexpr int LDS_MISC = LDS_ROPE + 4096;
constexpr int LDS_MOE = LDS_MISC + 256;
constexpr int LDS_BIAS = LDS_MOE + 1024;
constexpr int LDS_BYTES = 147456;
static_assert(LDS_BIAS + 2048 <= LDS_BYTES, "lds map");

struct Args {
    const float* in[33];
    float* out; unsigned char* ws;
    int ph_lo, ph_hi;
};
enum { I_x = 0, I_c, I_ctx, I_cctx, I_modw, I_modb, I_n1g, I_n2g, I_win, I_qng, I_wqb, I_kvng, I_wkvb, I_rpb, I_wout, I_fg, I_fu, I_fd, I_s5in, I_are, I_aim, I_lstep, I_bre, I_bim, I_cre, I_cim, I_odd, I_wglu,
       I_router, I_mg, I_mu, I_md, I_fing };

struct Frame {
    LAS unsigned char* lds;
    int tid, lane, wave, vcu, G, tailconv, wait_adaln;
    const Args* a;
    unsigned char* ws;
};
__device__ __forceinline__ int cond_of_tile(int pm) { return pm < 64 ? (pm >> 4) : NB; }
__device__ __forceinline__ int cond_of_row(int row) { return row < ML ? row / SEQ : NB; }

struct ConvSrc { const float* src; int ld; int col0; int perm; float scale; const float* gain; };
__device__ __forceinline__ int rope_src_dim(int c) { return (c & 16) + ((c & 1) ? 8 : 0) + ((c & 15) >> 1); }
struct ConvItem { ConvSrc cs; bf16_t* dst; int ldd, n0, k0; };
__device__ __forceinline__ void conv_load(const ConvItem& ci, f32x4 (&v)[8], int lane) {
    if (ci.cs.col0 >= 0) {
        const int c4 = 4 * (lane & 7), r8 = lane >> 3;
        const float* sp = ci.cs.src + (size_t)(ci.k0 + r8) * ci.cs.ld + ci.cs.col0 + c4;
#pragma unroll
        for (int i = 0; i < 8; ++i) v[i] = *(const f32x4*)(sp + (size_t)(8 * i) * ci.cs.ld);
    }
}
__device__ __forceinline__ void conv_finish(const ConvItem& ci, const f32x4 (&v)[8], LAS float* scr, int lane) {
    const ConvSrc& cs = ci.cs;
    if (cs.col0 >= 0) {
        const int c4 = 4 * (lane & 7), r8 = lane >> 3;
#pragma unroll
        for (int i = 0; i < 8; ++i) { const int kk = r8 + 8 * i; float g = cs.scale; if (cs.gain) g *= cs.gain[ci.k0 + kk];
            scr[kk * 33 + c4] = v[i].x * g; scr[kk * 33 + c4 + 1] = v[i].y * g; scr[kk * 33 + c4 + 2] = v[i].z * g; scr[kk * 33 + c4 + 3] = v[i].w * g; }
    }
    asm volatile("s_waitcnt lgkmcnt(0)" ::: "memory");
    const int c = lane & 7;
#pragma unroll
    for (int j = 0; j < 4; ++j) { const int n = (lane >> 3) + 8 * j; const int ns = cs.perm ? rope_src_dim(n) : n; const LAS float* s = scr + (8 * c) * 33 + ns;
        u32x4 o;
        if (cs.col0 >= 0) { o.x = cvt_pk_bf16(s[0 * 33], s[1 * 33]); o.y = cvt_pk_bf16(s[2 * 33], s[3 * 33]); o.z = cvt_pk_bf16(s[4 * 33], s[5 * 33]); o.w = cvt_pk_bf16(s[6 * 33], s[7 * 33]); }
        else o = (u32x4){0u, 0u, 0u, 0u};
        *(u32x4*)(ci.dst + (size_t)(ci.n0 + n) * ci.ldd + ci.k0 + 8 * c) = o; }
    asm volatile("s_waitcnt lgkmcnt(0)" ::: "memory");
}
__device__ __forceinline__ ConvSrc gu_src(const float* ga, const float* gb, int ld, int n0) { const int tile = n0 >> 8, w = n0 & 255; ConvSrc c; c.src = w < 128 ? ga : gb; c.ld = ld; c.col0 = tile * 128 + (w & 127); c.perm = 0; c.scale = 1.f; c.gain = nullptr; return c; }

__device__ __forceinline__ f32x4 s5_disc(const Args& a, int g, int dir, int p) {
    const float dt = expf(a.in[I_lstep][dir * 64 + g]); const float ar = a.in[I_are][(dir * 64 + g) * 64 + p], ai = a.in[I_aim][(dir * 64 + g) * 64 + p];
    const float decay = expf(ar * dt), abr = decay * cosf(ai * dt), abi = decay * sinf(ai * dt), den = ar * ar + ai * ai;
    const float fr = ((abr - 1.f) * ar + abi * ai) / den, fi = (abi * ar - (abr - 1.f) * ai) / den;
    return (f32x4){ar * dt, ai * dt, fr, fi};
}
__device__ __forceinline__ f32x2 cpow(float ardt, float aidt, float n) { const float m = __builtin_amdgcn_exp2f(ardt * n * LOG2E), rev = aidt * n * 0.15915494309189535f; return (f32x2){m * __builtin_amdgcn_cosf(rev), m * __builtin_amdgcn_sinf(rev)}; }

constexpr int CI_WIN0 = 0, CN_WIN0 = (D / 64) * (NIN / 32);
constexpr int CI_WQB = CI_WIN0 + CN_WIN0, CN_WQB = (384 / 64) * (768 / 32);
constexpr int CI_WKVB = CI_WQB + CN_WQB, CN_WKVB = (256 / 64) * (1024 / 32);
constexpr int CI_WOUT = CI_WKVB + CN_WKVB, CN_WOUT = (D / 64) * (D / 32);
constexpr int CI_WFGU = CI_WOUT + CN_WOUT, CN_WFGU = (D / 64) * (5632 / 32);
constexpr int CI_WFD = CI_WFGU + CN_WFGU, CN_WFD = (DFF / 64) * (D / 32);
constexpr int CI_WS5 = CI_WFD + CN_WFD, CN_WS5 = (D / 64) * (D / 32);
constexpr int CI_WGLU = CI_WS5 + CN_WS5, CN_WGLU = (D / 64) * (2048 / 32);
constexpr int CI_MGU = CI_WGLU + CN_WGLU, CN_MGU1 = (D / 64) * (7168 / 32), CN_MGU = NE * CN_MGU1;
constexpr int CI_MD = CI_MGU + CN_MGU, CN_MD1 = (DFE / 64) * (D / 32), CN_MD = NE * CN_MD1;
#ifndef TC_P0
#define TC_P0 1792
#endif
constexpr int CI_KK = CI_MD + CN_MD, CN_KK = 64 * 2 * TCH;
constexpr int CI_BH = CI_KK + CN_KK, CN_BH = 64 * 2;
constexpr int CI_END = CI_BH + CN_BH;

__device__ __forceinline__ ConvItem conv_decode(const Args& a, unsigned char* ws, int it) {
    ConvItem ci;
        if (it < CI_MGU) {
            ConvSrc cs; cs.perm = 0; cs.scale = 1.f; cs.gain = nullptr; bf16_t* dst; int ldd, n0, k0;
            if (it < CI_WQB) { const int r = it - CI_WIN0, nblk = NIN / 32; k0 = 64 * (r / nblk); n0 = 32 * (r % nblk); dst = (bf16_t*)(ws + WS_WIN0); ldd = D;
                cs.src = a.in[I_win]; cs.ld = 2208; cs.col0 = n0 < 2208 ? n0 : -1; cs.perm = (n0 == 640); cs.scale = (n0 >= 672 && n0 < 1184) ? C2_NA : 1.f; }
            else if (it < CI_WKVB) { const int r = it - CI_WQB, nblk = 768 / 32; k0 = 64 * (r / nblk); n0 = 32 * (r % nblk); dst = (bf16_t*)(ws + WS_WQB); ldd = 384;
                cs.src = a.in[I_wqb]; cs.ld = 768; cs.col0 = n0; cs.perm = ((n0 % 96) == 64); cs.gain = a.in[I_qng]; }
            else if (it < CI_WOUT) { const int r = it - CI_WKVB, nblk = 1024 / 32; k0 = 64 * (r / nblk); n0 = 32 * (r % nblk); dst = (bf16_t*)(ws + WS_WKVB); ldd = 256;
                cs.src = a.in[I_wkvb]; cs.ld = 1024; cs.col0 = n0; cs.gain = a.in[I_kvng]; }
            else if (it < CI_WFGU) { const int r = it - CI_WOUT, nblk = D / 32; k0 = 64 * (r / nblk); n0 = 32 * (r % nblk); dst = (bf16_t*)(ws + WS_WOUT); ldd = D; cs.src = a.in[I_wout]; cs.ld = D; cs.col0 = n0; }
            else if (it < CI_WFD) { const int r = it - CI_WFGU, nblk = 5632 / 32; k0 = 64 * (r / nblk); n0 = 32 * (r % nblk); dst = (bf16_t*)(ws + WS_WFGU); ldd = D; cs = gu_src(a.in[I_fg], a.in[I_fu], DFF, n0); }
            else if (it < CI_WS5) { const int r = it - CI_WFD, nblk = D / 32; k0 = 64 * (r / nblk); n0 = 32 * (r % nblk); dst = (bf16_t*)(ws + WS_WFD); ldd = LDF; cs.src = a.in[I_fd]; cs.ld = D; cs.col0 = n0; }
            else if (it < CI_WGLU) { const int r = it - CI_WS5, nblk = D / 32; k0 = 64 * (r / nblk); n0 = 32 * (r % nblk); dst = (bf16_t*)(ws + WS_WS5); ldd = D; cs.src = a.in[I_s5in]; cs.ld = D; cs.col0 = n0; }
            else { const int r = it - CI_WGLU, nblk = 2048 / 32; k0 = 64 * (r / nblk); n0 = 32 * (r % nblk); dst = (bf16_t*)(ws + WS_WGLU); ldd = D; cs = gu_src(a.in[I_wglu], a.in[I_wglu] + 1024, 2048, n0); }
            ci.cs = cs; ci.dst = dst; ci.ldd = ldd; ci.n0 = n0; ci.k0 = k0;
        } else if (it < CI_MD) {
            const int r0 = it - CI_MGU, e = r0 / CN_MGU1, r = r0 % CN_MGU1, nblk = 7168 / 32; const int k0 = 64 * (r / nblk), n0 = 32 * (r % nblk);
            ConvSrc cs = gu_src(a.in[I_mg] + (size_t)e * D * DFE, a.in[I_mu] + (size_t)e * D * DFE, DFE, n0);
            ci.cs = cs; ci.dst = (bf16_t*)(ws + WS_WMOE_GU) + (size_t)e * 7168 * D; ci.ldd = D; ci.n0 = n0; ci.k0 = k0;
        } else if (it < CI_KK) {
            const int r0 = it - CI_MD, e = r0 / CN_MD1, r = r0 % CN_MD1, nblk = D / 32; const int k0 = 64 * (r / nblk), n0 = 32 * (r % nblk);
            ConvSrc cs; cs.src = a.in[I_md] + (size_t)e * DFE * D; cs.ld = D; cs.col0 = n0; cs.perm = 0; cs.scale = 1.f; cs.gain = nullptr;
            ci.cs = cs; ci.dst = (bf16_t*)(ws + WS_WMOE_D) + (size_t)e * D * DFE; ci.ldd = DFE; ci.n0 = n0; ci.k0 = k0;
        }
    return ci;
}
__device__ __forceinline__ void conv4(const Args& a, unsigned char* ws, const int (&it)[4], const bool (&ok)[4], LAS float* scr, int lane) {
    ConvItem ci[4]; f32x4 v[4][8];
#pragma unroll
    for (int i = 0; i < 4; ++i) if (ok[i]) { ci[i] = conv_decode(a, ws, it[i]); conv_load(ci[i], v[i], lane); }
#pragma unroll
    for (int i = 0; i < 4; ++i) if (ok[i]) conv_finish(ci[i], v[i], scr, lane);
}
__device__ __forceinline__ void p0_prologue(Frame& F, int qsel) {
    const Args& a = *F.a; unsigned char* ws = F.ws;
    {
        LAS float* part = (LAS float*)F.lds;
        LAS float* scnd = part + 8 * 5 * 64;
        float* modp = (float*)(ws + WS_MODP);
        if ((int)blockIdx.x < 2 * 96) {
            for (int i = F.tid; i < 5 * D; i += NTHR) { const int r = i >> 10, k = i & 1023; const float cv = r < 4 ? a.in[I_c][r * D + k] : a.in[I_cctx][k]; scnd[i] = cv * fast_sigmoid(cv); }
            __syncthreads();
        }
        for (int it = blockIdx.x; it < 2 * 96; it += F.G) {
            const int l = it / 96, cb = it % 96, col = cb * 64 + F.lane;
            const float* W = a.in[I_modw] + (size_t)l * D * 6144 + col;
            float acc[5] = {0.f, 0.f, 0.f, 0.f, 0.f};
            const int kb = F.wave * 128;
#pragma unroll 2
            for (int k0 = kb; k0 < kb + 128; k0 += 16) {
                float wv[16];
#pragma unroll
                for (int j = 0; j < 16; ++j) wv[j] = W[(size_t)(k0 + j) * 6144];
#pragma unroll
                for (int j = 0; j < 16; ++j)
#pragma unroll
                    for (int r = 0; r < 5; ++r) acc[r] += scnd[r * D + k0 + j] * wv[j];
            }
#pragma unroll
            for (int r = 0; r < 5; ++r) part[(F.wave * 5 + r) * 64 + F.lane] = acc[r];
            __syncthreads();
            if (F.wave < 5) { const int r = F.wave; float sum = 0.f;
#pragma unroll
                for (int w = 0; w < 8; ++w) sum += part[(w * 5 + r) * 64 + F.lane];
                modp[(l * 5 + r) * 6144 + col] = sum + a.in[I_modb][l * 6144 + col]; }
            asm volatile("s_waitcnt vmcnt(0)" ::: "memory");
            __syncthreads();
            if (F.tid == 0) { __builtin_amdgcn_fence(__ATOMIC_RELEASE, "agent"); asm volatile("s_waitcnt vmcnt(0)" ::: "memory");
                (void)__hip_atomic_fetch_add((unsigned*)(ws + WS_CTL + CTL_ADALN), 1u, __ATOMIC_RELAXED, __HIP_MEMORY_SCOPE_AGENT); }
        }
    }
    LAS float* scr = (LAS float*)(F.lds + F.wave * 16384);
    const int gw = F.vcu * NWAVES + F.wave, NGW = F.G * NWAVES, lane = F.lane;
    unsigned* qctr = (unsigned*)(ws + WS_CTL + CTL_Q0) + 64 * qsel;
    const int conv_end = F.tailconv ? CI_MGU + 8 * TC_P0 : CI_KK;
    constexpr int QB_KK = CN_BH / 8, QB_CONV = QB_KK + CN_KK / 32; const int QB_END = QB_CONV + (conv_end + 127) / 128;
    constexpr int QC_KK = CN_BH, QC_CONV = QC_KK + CN_KK / 4;
    volatile LAS int* qslot = (volatile LAS int*)(F.lds + LDS_MISC + 64);
    for (;;) {
      __syncthreads();
      if (F.tid == 0) qslot[0] = (int)__hip_atomic_fetch_add(qctr, 1u, __ATOMIC_RELAXED, __HIP_MEMORY_SCOPE_AGENT);
      __syncthreads();
      const int cbk = __builtin_amdgcn_readfirstlane(qslot[0]); if (cbk >= QB_END) break;
      const int c = cbk < QB_KK ? cbk * 8 + F.wave : (cbk < QB_CONV ? QC_KK + (cbk - QB_KK) * 8 + F.wave : QC_CONV + (cbk - QB_CONV));
      if (c < QC_KK) { const int it = c;
            const int r = it, g = r >> 1, dir = r & 1, p = lane;
            const f32x4 dsc = s5_disc(a, g, dir, p);
            float br[16], bi[16];
            const float* bre = a.in[I_bre] + ((size_t)(dir * 64 + g) * 64 + p) * 16; const float* bim = a.in[I_bim] + ((size_t)(dir * 64 + g) * 64 + p) * 16;
#pragma unroll
            for (int i = 0; i < 16; ++i) { const float x = bre[i], y = bim[i]; br[i] = dsc.z * x - dsc.w * y; bi[i] = dsc.z * y + dsc.w * x; }
            bf16_t* rowr = (bf16_t*)(ws + WS_BHAT) + ((size_t)g * 256 + dir * 128 + p) * SK; bf16_t* rowi = rowr + (size_t)64 * SK;
            const f32x2 a1 = cpow(dsc.x, dsc.y, 1.f); f32x2 ap = (f32x2){1.f, 0.f};
            for (int e = 0; e < TCH; ++e) {
                const int s = dir ? e : TCH - 1 - e;
                u32x4 o0, o1, q0, q1; float vr[16], vi[16];
#pragma unroll
                for (int i = 0; i < 16; ++i) { vr[i] = ap.x * br[i] - ap.y * bi[i]; vi[i] = ap.x * bi[i] + ap.y * br[i]; }
                o0 = (u32x4){cvt_pk_bf16(vr[0], vr[1]), cvt_pk_bf16(vr[2], vr[3]), cvt_pk_bf16(vr[4], vr[5]), cvt_pk_bf16(vr[6], vr[7])}; o1 = (u32x4){cvt_pk_bf16(vr[8], vr[9]), cvt_pk_bf16(vr[10], vr[11]), cvt_pk_bf16(vr[12], vr[13]), cvt_pk_bf16(vr[14], vr[15])};
                q0 = (u32x4){cvt_pk_bf16(vi[0], vi[1]), cvt_pk_bf16(vi[2], vi[3]), cvt_pk_bf16(vi[4], vi[5]), cvt_pk_bf16(vi[6], vi[7])}; q1 = (u32x4){cvt_pk_bf16(vi[8], vi[9]), cvt_pk_bf16(vi[10], vi[11]), cvt_pk_bf16(vi[12], vi[13]), cvt_pk_bf16(vi[14], vi[15])};
                *(u32x4*)(rowr + s * 16) = o0; *(u32x4*)(rowr + s * 16 + 8) = o1; *(u32x4*)(rowi + s * 16) = q0; *(u32x4*)(rowi + s * 16 + 8) = q1;
                ap = (f32x2){ap.x * a1.x - ap.y * a1.y, ap.x * a1.y + ap.y * a1.x};
            }
      } else if (c < QC_CONV) {
        const int ck = c - QC_KK, g = ck >> 4, dir = (ck >> 3) & 1, tau0 = (ck & 7) * 4;
        { const f32x4* s0 = (const f32x4*)(a.in[I_cre] + (size_t)(dir * 64 + g) * 1024); const f32x4* s1 = (const f32x4*)(a.in[I_cim] + (size_t)(dir * 64 + g) * 1024);
          const f32x4* s2 = (const f32x4*)(a.in[I_bre] + (size_t)(dir * 64 + g) * 1024); const f32x4* s3 = (const f32x4*)(a.in[I_bim] + (size_t)(dir * 64 + g) * 1024);
          f32x4 t0[4], t1[4], t2[4], t3[4];
#pragma unroll
          for (int j = 0; j < 4; ++j) { t0[j] = s0[lane + 64 * j]; t1[j] = s1[lane + 64 * j]; t2[j] = s2[lane + 64 * j]; t3[j] = s3[lane + 64 * j]; }
#pragma unroll
          for (int j = 0; j < 4; ++j) { ((LAS f32x4*)scr)[lane + 64 * j] = t0[j]; ((LAS f32x4*)scr)[256 + lane + 64 * j] = t1[j]; ((LAS f32x4*)scr)[512 + lane + 64 * j] = t2[j]; ((LAS f32x4*)scr)[768 + lane + 64 * j] = t3[j]; } }
        asm volatile("s_waitcnt lgkmcnt(0)" ::: "memory");
        const f32x4 dsc = s5_disc(a, g, dir, lane);
        const int o = lane >> 2, i0 = 4 * (lane & 3);
        const LAS float* Cr = scr + o * 64; const LAS float* Ci = scr + 1024 + o * 64; const LAS float* Br = scr + 2048 + i0; const LAS float* Bi = scr + 3072 + i0;
        for (int tt = 0; tt < 4; ++tt) {
            const int tau = tau0 + tt;
            const f32x2 ap = cpow(dsc.x, dsc.y, (float)tau);
            const float gr_ = ap.x * dsc.z - ap.y * dsc.w, gi_ = ap.x * dsc.w + ap.y * dsc.z;
            f32x4 acc = (f32x4){0.f, 0.f, 0.f, 0.f};
#pragma unroll 8
            for (int p = 0; p < 64; ++p) {
                const float xr = __builtin_bit_cast(float, __builtin_amdgcn_readlane(__builtin_bit_cast(int, gr_), p)), xi = __builtin_bit_cast(float, __builtin_amdgcn_readlane(__builtin_bit_cast(int, gi_), p));
                const float cr = Cr[p], ci = Ci[p];
                const float hr = cr * xr - ci * xi, hi = cr * xi + ci * xr;
                const f32x4 br = *(const LAS f32x4*)(Br + p * 16), bi = *(const LAS f32x4*)(Bi + p * 16);
                acc += hr * br - hi * bi;
            }
            *(f32x4*)((float*)(ws + WS_KKER) + ((size_t)((g * 2 + dir) * TCH + tau) * 16 + o) * 16 + i0) = acc;
        }
        asm volatile("s_waitcnt lgkmcnt(0)" ::: "memory");
      } else {
        const int itb = (c - QC_CONV) * 128 + F.wave; const int ite = ((c - QC_CONV) * 128 + 128 < conv_end) ? (c - QC_CONV) * 128 + 128 : conv_end;
        for (int it0 = itb; it0 < ite; it0 += 32) {
            int it[4]; bool ok[4];
#pragma unroll
            for (int i = 0; i < 4; ++i) { it[i] = it0 + 8 * i; ok[i] = it[i] < ite; }
            conv4(a, ws, it, ok, scr, lane);
        }
      }
    }
    (void)gw; (void)NGW;
}

constexpr int TC_CHUNKS = (CI_KK - CI_MGU) / 8;
__device__ __forceinline__ void tail_convert(Frame& F, int cb, int ce, int j, int n_idle) {
    const Args& a = *F.a; unsigned char* ws = F.ws; LAS float* scr = (LAS float*)(F.lds + F.wave * 16384); const int lane = F.lane;
    if (ce > TC_CHUNKS) ce = TC_CHUNKS;
    for (int ch = cb + j; ch < ce; ch += 4 * n_idle) {
        int it[4]; bool ok[4];
#pragma unroll
        for (int i = 0; i < 4; ++i) { const int c = ch + i * n_idle; ok[i] = c < ce; it[i] = CI_MGU + c * 8 + F.wave; }
        conv4(a, ws, it, ok, scr, lane);
    }
}
template <int NR, bool RES, bool TO_LDS = false>
__device__ __forceinline__ void modulate_rows(const float* const (&xrow)[NR], const bf16_t* const (&yrow)[NR], const float* const (&gate)[NR], float* const (&xout)[NR],
                                              const float* g, const float* const (&mpsh)[NR], const float* const (&mpsc)[NR], bf16_t* const (&orow)[NR], int lane, f32x4 (&v)[NR][4], LAS u32x2* const* lrow = nullptr) {
    u32x2 yv[NR][4];
#pragma unroll
    for (int r = 0; r < NR; ++r) if (xrow[r]) {
#pragma unroll
        for (int j = 0; j < 4; ++j) { v[r][j] = ((const f32x4*)xrow[r])[lane + 64 * j]; if (RES) yv[r][j] = ((const u32x2*)yrow[r])[lane + 64 * j]; } }
    f32x4 gg[4];
#pragma unroll
    for (int j = 0; j < 4; ++j) gg[j] = ((const f32x4*)g)[lane + 64 * j];
#pragma unroll
    for (int r = 0; r < NR; ++r) if (xrow[r]) {
        float s = 0.f;
#pragma unroll
        for (int j = 0; j < 4; ++j) {
            if (RES) { const f32x4 gt = ((const f32x4*)gate[r])[lane + 64 * j]; v[r][j] = v[r][j] + gt * (f32x4){bf_lo(yv[r][j].x), bf_hi(yv[r][j].x), bf_lo(yv[r][j].y), bf_hi(yv[r][j].y)}; ((f32x4*)xout[r])[lane + 64 * j] = v[r][j]; }
            s += (v[r][j].x * v[r][j].x + v[r][j].y * v[r][j].y) + (v[r][j].z * v[r][j].z + v[r][j].w * v[r][j].w); }
        const float rs = rsqrtf(wave_sum(s) * (1.f / D) + EPS);
#pragma unroll
        for (int j = 0; j < 4; ++j) { const f32x4 s1 = ((const f32x4*)mpsc[r])[lane + 64 * j], s0 = ((const f32x4*)mpsh[r])[lane + 64 * j];
            v[r][j] = v[r][j] * rs * gg[j] * (1.f + s1) + s0;
            const u32x2 pk = (u32x2){cvt_pk_bf16(v[r][j].x, v[r][j].y), cvt_pk_bf16(v[r][j].z, v[r][j].w)};
            if (TO_LDS) lrow[r][lane + 64 * j] = pk; else *((u32x2*)orow[r] + lane + 64 * j) = pk; }
    }
}
__device__ __forceinline__ void ctx_row_part(const float* xin, float* xout, const float* part, int S, int r, const float* gate, const float* g, const float* sh, const float* sc, bf16_t* orow, int lane) {
    f32x4 v[4], y[4];
#pragma unroll
    for (int j = 0; j < 4; ++j) { v[j] = ((const f32x4*)xin)[lane + 64 * j]; y[j] = (f32x4){0.f, 0.f, 0.f, 0.f}; }
    for (int s = 0; s < S; ++s) { const f32x4* pp = (const f32x4*)(part + ((size_t)s * MC + r) * D);
#pragma unroll
        for (int j = 0; j < 4; ++j) y[j] += pp[lane + 64 * j]; }
    float ss = 0.f;
#pragma unroll
    for (int j = 0; j < 4; ++j) { v[j] = v[j] + ((const f32x4*)gate)[lane + 64 * j] * y[j]; ((f32x4*)xout)[lane + 64 * j] = v[j]; ss += (v[j].x * v[j].x + v[j].y * v[j].y) + (v[j].z * v[j].z + v[j].w * v[j].w); }
    const float rs = rsqrtf(wave_sum(ss) * (1.f / D) + EPS);
#pragma unroll
    for (int j = 0; j < 4; ++j) { const f32x4 o = v[j] * rs * ((const f32x4*)g)[lane + 64 * j] * (1.f + ((const f32x4*)sc)[lane + 64 * j]) + ((const f32x4*)sh)[lane + 64 * j];
        *((u32x2*)orow + lane + 64 * j) = (u32x2){cvt_pk_bf16(o.x, o.y), cvt_pk_bf16(o.z, o.w)}; }
}
__device__ __forceinline__ const float* xrow_ptr(const Frame& F, int row) { return row < ML ? F.a->out + (size_t)row * D : (const float*)(F.ws + WS_XC) + (size_t)(row - ML) * D; }

__device__ __forceinline__ void lt_expand(Frame& F, int first, int stride) {
    const Args& a = *F.a; unsigned char* ws = F.ws; const int lane = F.lane;
    const float* KK = (const float*)(ws + WS_KKER);
    for (int it = first; it < 64 * TCH; it += stride) {
        const int g = it / TCH, t = it % TCH;
        bf16_t* base = (bf16_t*)(ws + WS_LT) + ((size_t)g * 512 + t * 16) * SKA;
        const int s = lane >> 1, i0 = (lane & 1) * 8;
        const int sdir = lane >> 5, scomp = (lane >> 4) & 1, p0 = 4 * (lane & 15);
        f32x2 ap[4];
#pragma unroll
        for (int j = 0; j < 4; ++j) { const f32x4 dsc = s5_disc(a, g, sdir, p0 + j); ap[j] = cpow(dsc.x, dsc.y, (float)(sdir ? TCH - t : t + 1)); }
#pragma unroll 4
        for (int o = 0; o < 16; ++o) {
            const float mf = (t >= s) ? 1.f : 0.f, mr = (t <= s) ? 1.f : 0.f; const int df = t >= s ? t - s : 0, dr = s >= t ? s - t : 0;
            const float* kf = KK + ((size_t)((g * 2 + 0) * TCH + df) * 16 + o) * 16 + i0; const float* kr = KK + ((size_t)((g * 2 + 1) * TCH + dr) * 16 + o) * 16 + i0;
            const f32x4 lo = mf * *(const f32x4*)kf + mr * *(const f32x4*)kr, hi = mf * *(const f32x4*)(kf + 4) + mr * *(const f32x4*)(kr + 4);
            bf16_t* rowp = base + (size_t)o * SKA;
            *(u32x4*)(rowp + s * 16 + i0) = (u32x4){cvt_pk_bf16(lo.x, lo.y), cvt_pk_bf16(lo.z, lo.w), cvt_pk_bf16(hi.x, hi.y), cvt_pk_bf16(hi.z, hi.w)};
            const float* cre = a.in[I_cre] + (size_t)((sdir * 64 + g) * 16 + o) * 64 + p0; const float* cim = a.in[I_cim] + (size_t)((sdir * 64 + g) * 16 + o) * 64 + p0;
            float w[4];
#pragma unroll
            for (int j = 0; j < 4; ++j) { const float cr = cre[j], ci = cim[j]; w[j] = scomp ? -(cr * ap[j].y + ci * ap[j].x) : (cr * ap[j].x - ci * ap[j].y); }
            *(u32x2*)(rowp + SK + 4 * lane) = (u32x2){cvt_pk_bf16(w[0], w[1]), cvt_pk_bf16(w[2], w[3])};
        }
    }
}

__device__ __forceinline__ void p1_phase(Frame& F) {
    const Args& a = *F.a; unsigned char* ws = F.ws; const int gw = F.vcu * NWAVES + F.wave, NGW = F.G * NWAVES, lane = F.lane;
    const float* modp = (const float*)(ws + WS_MODP);
    if (F.wait_adaln) {
        if (F.tid == 0) { unsigned* cnt = (unsigned*)(ws + WS_CTL + CTL_ADALN); unsigned sp = 0;
            while (__hip_atomic_load(cnt, __ATOMIC_RELAXED, __HIP_MEMORY_SCOPE_AGENT) < 192u) { __builtin_amdgcn_s_sleep(2); if (++sp > (1u << 20)) break; }
            __builtin_amdgcn_fence(__ATOMIC_ACQUIRE, "agent"); asm volatile("s_waitcnt vmcnt(0)" ::: "memory"); }
        __syncthreads();
    }
    for (int row0 = gw; row0 < MT; row0 += 3 * NGW) {
        const float* xr[3]; const float* sh[3]; const float* sc[3]; bf16_t* orow[3]; f32x4 v[3][4];
#pragma unroll
        for (int r = 0; r < 3; ++r) { const int row = row0 + r * NGW; const bool ok = row < MT; const int rw = ok ? row : 0;
            xr[r] = ok ? (rw < ML ? a.in[I_x] + (size_t)rw * D : a.in[I_ctx] + (size_t)(rw - ML) * D) : nullptr; const float* mp = modp + (size_t)cond_of_row(rw) * 6144; sh[r] = mp; sc[r] = mp + 1024; orow[r] = (bf16_t*)(ws + WS_HB) + (size_t)rw * D; }
        const bf16_t* yn[3] = {nullptr, nullptr, nullptr}; const float* gn[3] = {nullptr, nullptr, nullptr}; float* xo[3] = {nullptr, nullptr, nullptr};
        modulate_rows<3, false>(xr, yn, gn, xo, a.in[I_n1g], sh, sc, orow, lane, v);
    }
    if (!F.tailconv) lt_expand(F, gw, NGW);
}
}
namespace fp {
using pg8::Unit;
typedef f32x4 Acc[2][2][4][2];
#ifndef WT_STORE
#define WT_STORE 0
#endif
__device__ __forceinline__ void st16(bf16_t* base, size_t elem_off, u32x4 v, __amdgpu_buffer_rsrc_t rs) {
    if (WT_STORE) __builtin_amdgcn_raw_buffer_store_b128(v, rs, (int)(unsigned)(elem_off * 2), 0, 16); else *(u32x4*)(base + elem_off) = v; }
__device__ __forceinline__ __amdgpu_buffer_rsrc_t mk_rsrc(const void* p, unsigned nbytes) { return __builtin_amdgcn_make_buffer_rsrc((void*)p, (short)0, (int)nbytes, 0x00020000); }
#define EPI_ROWS_BEGIN _Pragma("unroll") for (int ai = 0; ai < 2; ++ai) _Pragma("unroll") for (int m = 0; m < 4; ++m) { const int tr = 128 * ai + 64 * wr + 16 * m + fr;
#define EPI_ROWS_END }

struct SchedPlain {
    pg8::Order o; const bf16_t* A; const bf16_t* Bt; int lda, ldb, nt;
    __device__ __forceinline__ int ktiles(const Unit&) const { return nt; }
    __device__ __forceinline__ bool next(int i, Unit& u) const { return o.next(i, u); }
    __device__ __forceinline__ const char* aptr(const Unit& u) const { return (const char*)(A + (size_t)u.pm * 256 * lda); }
    __device__ __forceinline__ const char* bptr(const Unit& u) const { return (const char*)(Bt + (size_t)u.pn * 256 * ldb); }
};

struct EpiInProj {
    bf16_t* P; float* ssq; bf16_t* Kf; const LAS f32x2* rope;
    __device__ __forceinline__ void operator()(const Acc& acc, const Unit& u, int wr, int wc, int fr, int fq) const {
        EPI_ROWS_BEGIN
            const int row = u.pm * 256 + tr;
#pragma unroll
            for (int bj = 0; bj < 2; ++bj) {
                const int col8 = u.pn * 256 + 128 * bj + 32 * wc + 8 * fq;
                const f32x4 v0 = acc[ai][bj][m][0], v1 = acc[ai][bj][m][1];
                *(u32x4*)(P + (size_t)row * NIN + col8) = (u32x4){cvt_pk_bf16(v0[0], v0[1]), cvt_pk_bf16(v0[2], v0[3]), cvt_pk_bf16(v1[0], v1[1]), cvt_pk_bf16(v1[2], v1[3])};
                const int cb = u.pn * 2 + bj;
                if (cb < 5) {
                    float s = (v0[0] * v0[0] + v0[1] * v0[1]) + (v0[2] * v0[2] + v0[3] * v0[3]) + (v1[0] * v1[0] + v1[1] * v1[1]) + (v1[2] * v1[2] + v1[3] * v1[3]);
                    s += __shfl_xor(s, 16); s += __shfl_xor(s, 32);
                    if (fq == 0) ssq[(size_t)row * 20 + cb * 4 + wc] = s;
                } else if (cb == 5 && wc == 0) {
                    float x[8] = {v0[0], v0[1], v0[2], v0[3], v1[0], v1[1], v1[2], v1[3]};
                    if (row < ML) { const int t = row & (SEQ - 1), gr = t >> 6, gc = t & 63;
#pragma unroll
                        for (int e = 0; e < 4; ++e) { const int pi = 4 * fq + e; const f32x2 cs = rope[(pi < 8 ? gr : gc) * 8 + (pi & 7)]; const float x1 = x[2 * e], x2 = x[2 * e + 1]; x[2 * e] = x1 * cs.x - x2 * cs.y; x[2 * e + 1] = x1 * cs.y + x2 * cs.x; } }
                    const u32x4 w = (u32x4){cvt_pk_bf16(x[0], x[1]), cvt_pk_bf16(x[2], x[3]), cvt_pk_bf16(x[4], x[5]), cvt_pk_bf16(x[6], x[7])};
#pragma unroll
                    for (int h = 0; h < 8; ++h) *(u32x4*)(Kf + (size_t)row * 768 + h * 96 + 64 + 8 * fq) = w;
                }
            }
        EPI_ROWS_END
    }
};
struct EpiQb {
    bf16_t* Q; const float* ssq; const LAS f32x2* rope;
    __device__ __forceinline__ void operator()(const Acc& acc, const Unit& u, int wr, int wc, int fr, int fq) const {
        EPI_ROWS_BEGIN
            const int row = u.pm * 256 + tr; const f32x4 q0 = *(const f32x4*)(ssq + (size_t)row * 20), q1 = *(const f32x4*)(ssq + (size_t)row * 20 + 4), q2 = *(const f32x4*)(ssq + (size_t)row * 20 + 8);
            const float rs = rsqrtf((((q0[0] + q0[1]) + (q0[2] + q0[3])) + ((q1[0] + q1[1]) + (q1[2] + q1[3])) + ((q2[0] + q2[1]) + (q2[2] + q2[3]))) * (1.f / 384.f) + EPS) * C2_MLA;
            const int t = row & (SEQ - 1), gr = t >> 6, gc = t & 63;
#pragma unroll
            for (int bj = 0; bj < 2; ++bj) {
                const int col8 = u.pn * 256 + 128 * bj + 32 * wc + 8 * fq; const int d0 = col8 % 96;
                const f32x4 v0 = acc[ai][bj][m][0] * rs, v1 = acc[ai][bj][m][1] * rs;
                float x[8] = {v0[0], v0[1], v0[2], v0[3], v1[0], v1[1], v1[2], v1[3]};
                if (d0 >= 64 && row < ML) { const int pb = (d0 - 64) >> 1;
#pragma unroll
                    for (int e = 0; e < 4; ++e) { const int pi = pb + e; const f32x2 cs = rope[(pi < 8 ? gr : gc) * 8 + (pi & 7)]; const float x1 = x[2 * e], x2 = x[2 * e + 1]; x[2 * e] = x1 * cs.x - x2 * cs.y; x[2 * e + 1] = x1 * cs.y + x2 * cs.x; } }
                *(u32x4*)(Q + (size_t)row * 768 + col8) = (u32x4){cvt_pk_bf16(x[0], x[1]), cvt_pk_bf16(x[2], x[3]), cvt_pk_bf16(x[4], x[5]), cvt_pk_bf16(x[6], x[7])};
            }
        EPI_ROWS_END
    }
};
struct EpiKvb {
    bf16_t* Kf; bf16_t* V; const float* ssq;
    __device__ __forceinline__ void operator()(const Acc& acc, const Unit& u, int wr, int wc, int fr, int fq) const {
        EPI_ROWS_BEGIN
            const int row = u.pm * 256 + tr; const f32x4 q0 = *(const f32x4*)(ssq + (size_t)row * 20 + 12), q1 = *(const f32x4*)(ssq + (size_t)row * 20 + 16);
            const float rs = rsqrtf((((q0[0] + q0[1]) + (q0[2] + q0[3])) + ((q1[0] + q1[1]) + (q1[2] + q1[3]))) * (1.f / 256.f) + EPS);
#pragma unroll
            for (int bj = 0; bj < 2; ++bj) {
                const int col8 = u.pn * 256 + 128 * bj + 32 * wc + 8 * fq; const int h = col8 >> 7, d0 = col8 & 127;
                const f32x4 v0 = acc[ai][bj][m][0] * rs, v1 = acc[ai][bj][m][1] * rs;
                const u32x4 w = (u32x4){cvt_pk_bf16(v0[0], v0[1]), cvt_pk_bf16(v0[2], v0[3]), cvt_pk_bf16(v1[0], v1[1]), cvt_pk_bf16(v1[2], v1[3])};
                if (d0 < 64) *(u32x4*)(Kf + (size_t)row * 768 + h * 96 + d0) = w; else *(u32x4*)(V + (size_t)row * 512 + h * 64 + (d0 - 64)) = w;
            }
        EPI_ROWS_END
    }
};
struct EpiResid {
    const float* xin_l; const float* xin_c; float* xout_l; float* xout_c; const float* gate;
    __device__ __forceinline__ void operator()(const Acc& acc, const Unit& u, int wr, int wc, int fr, int fq) const {
        const bool lat = u.pm < 64; const float* xin = lat ? xin_l + (size_t)u.pm * 256 * D : xin_c + (size_t)(u.pm - 64) * 256 * D; float* xout = lat ? xout_l + (size_t)u.pm * 256 * D : xout_c + (size_t)(u.pm - 64) * 256 * D;
        const float* gt = gate + (size_t)cond_of_tile(u.pm) * 6144;
#pragma unroll
        for (int bj = 0; bj < 2; ++bj) {
            const int col8 = u.pn * 256 + 128 * bj + 32 * wc + 8 * fq; const f32x4 g0 = *(const f32x4*)(gt + col8), g1 = *(const f32x4*)(gt + col8 + 4);
            EPI_ROWS_BEGIN
                const size_t off = (size_t)tr * D + col8; const f32x4 x0 = *(const f32x4*)(xin + off), x1 = *(const f32x4*)(xin + off + 4);
                *(f32x4*)(xout + off) = x0 + g0 * acc[ai][bj][m][0]; *(f32x4*)(xout + off + 4) = x1 + g1 * acc[ai][bj][m][1];
            EPI_ROWS_END
        }
    }
};
struct EpiSwiglu {
    bf16_t* O; int ldo; int ncol_tiles; unsigned nbytes;
    __device__ __forceinline__ void operator()(const Acc& acc, const Unit& u, int wr, int wc, int fr, int fq) const {
        const int col8 = (u.pn % ncol_tiles) * 128 + 32 * wc + 8 * fq; const __amdgpu_buffer_rsrc_t rs = mk_rsrc(O, nbytes);
        EPI_ROWS_BEGIN
            const size_t row = (size_t)u.pm * 256 + tr; float o[8];
#pragma unroll
            for (int n = 0; n < 2; ++n)
#pragma unroll
                for (int j = 0; j < 4; ++j) { const float g = acc[ai][0][m][n][j], up = acc[ai][1][m][n][j]; o[4 * n + j] = g * fast_sigmoid(g) * up; }
            st16(O, row * ldo + col8, (u32x4){cvt_pk_bf16(o[0], o[1]), cvt_pk_bf16(o[2], o[3]), cvt_pk_bf16(o[4], o[5]), cvt_pk_bf16(o[6], o[7])}, rs);
        EPI_ROWS_END
    }
};
struct EpiS5In {
    bf16_t* acat; bf16_t* acatc;
    __device__ __forceinline__ void operator()(const Acc& acc, const Unit& u, int wr, int wc, int fr, int fq) const {
        EPI_ROWS_BEGIN
            const int row = u.pm * 256 + tr;
#pragma unroll
            for (int bj = 0; bj < 2; ++bj) {
                const int col8 = u.pn * 256 + 128 * bj + 32 * wc + 8 * fq; const int g = col8 >> 4, i0 = col8 & 15;
                const f32x4 v0 = acc[ai][bj][m][0], v1 = acc[ai][bj][m][1];
                const u32x4 w = (u32x4){cvt_pk_bf16(v0[0], v0[1]), cvt_pk_bf16(v0[2], v0[3]), cvt_pk_bf16(v1[0], v1[1]), cvt_pk_bf16(v1[2], v1[3])};
                if (row < ML) *(u32x4*)(acat + ((size_t)g * 512 + (row >> 5)) * SKA + (row & 31) * 16 + i0) = w;
                else { const int j = row - ML; *(u32x4*)(acatc + ((size_t)g * 32 + (j >> 5)) * SKA + (j & 31) * 16 + i0) = w; }
            }
        EPI_ROWS_END
    }
};
struct SchedSloc {
    pg8::Order o; const bf16_t* acat; const bf16_t* acatc; const bf16_t* bhat;
    __device__ __forceinline__ int ktiles(const Unit&) const { return SK / 64; }
    __device__ __forceinline__ bool next(int i, Unit& u) const { return o.next(i, u); }
    __device__ __forceinline__ const char* aptr(const Unit& u) const { const int g = u.pm / 3, rt = u.pm % 3; return (const char*)(rt < 2 ? acat + ((size_t)g * 512 + rt * 256) * SKA : acatc + (size_t)g * 32 * SKA); }
    __device__ __forceinline__ const char* bptr(const Unit& u) const { return (const char*)(bhat + (size_t)(u.pm / 3) * 256 * SK); }
};
struct EpiSloc {
    float* sloc;
    __device__ __forceinline__ void operator()(const Acc& acc, const Unit& u, int wr, int wc, int fr, int fq) const {
        const int g = u.pm / 3, rt = u.pm % 3;
        EPI_ROWS_BEGIN
            if (rt < 2 || tr < 32) {
                float* rp = sloc + ((size_t)g * 544 + rt * 256 + tr) * 256;
#pragma unroll
                for (int bj = 0; bj < 2; ++bj) { const int col8 = 128 * bj + 32 * wc + 8 * fq; *(f32x4*)(rp + col8) = acc[ai][bj][m][0]; *(f32x4*)(rp + col8 + 4) = acc[ai][bj][m][1]; }
            }
        EPI_ROWS_END
    }
};
struct SchedS5Out {
    pg8::Order o; const bf16_t* acat; const bf16_t* lt;
    __device__ __forceinline__ int ktiles(const Unit&) const { return SKA / 64; }
    __device__ __forceinline__ bool next(int i, Unit& u) const { return o.next(i, u); }
    __device__ __forceinline__ const char* aptr(const Unit& u) const { return (const char*)(acat + ((size_t)(u.pm >> 1) * 512 + (u.pm & 1) * 256) * SKA); }
    __device__ __forceinline__ const char* bptr(const Unit& u) const { return (const char*)(lt + ((size_t)(u.pm >> 1) * 512 + u.pn * 256) * SKA); }
};
__device__ __forceinline__ float gelu_tanh_fast(float x) { const float uu = 0.7978845608028654f * (x + 0.044715f * x * x * x); return x * __builtin_amdgcn_rcpf(1.f + __builtin_amdgcn_exp2f(-2.f * LOG2E * uu)); }
struct EpiS5Out {
    const bf16_t* acat; const float* dskip; bf16_t* gb;
    __device__ __forceinline__ void operator()(const Acc& acc, const Unit& u, int wr, int wc, int fr, int fq) const {
        const int g = u.pm >> 1, rm = u.pm & 1;
        EPI_ROWS_BEGIN
            const int R = rm * 256 + tr;
#pragma unroll
            for (int bj = 0; bj < 2; ++bj) {
                const int n8 = u.pn * 256 + 128 * bj + 32 * wc + 8 * fq; const int t = n8 >> 4, o0 = n8 & 15;
                const u32x4 uw = *(const u32x4*)(acat + ((size_t)g * 512 + R) * SKA + n8);
                const f32x4 d0 = *(const f32x4*)(dskip + g * 16 + o0), d1 = *(const f32x4*)(dskip + g * 16 + o0 + 4);
                const f32x4 v0 = acc[ai][bj][m][0], v1 = acc[ai][bj][m][1];
                float y[8] = {v0[0] + d0[0] * bf_lo(uw.x), v0[1] + d0[1] * bf_hi(uw.x), v0[2] + d0[2] * bf_lo(uw.y), v0[3] + d0[3] * bf_hi(uw.y),
                              v1[0] + d1[0] * bf_lo(uw.z), v1[1] + d1[1] * bf_hi(uw.z), v1[2] + d1[2] * bf_lo(uw.w), v1[3] + d1[3] * bf_hi(uw.w)};
#pragma unroll
                for (int j = 0; j < 8; ++j) y[j] = gelu_tanh_fast(y[j]);
                *(u32x4*)(gb + ((size_t)R * 32 + t) * D + g * 16 + o0) = (u32x4){cvt_pk_bf16(y[0], y[1]), cvt_pk_bf16(y[2], y[3]), cvt_pk_bf16(y[4], y[5]), cvt_pk_bf16(y[6], y[7])};
            }
        EPI_ROWS_END
    }
};
struct EpiGlu {
    bf16_t* y;
    __device__ __forceinline__ void operator()(const Acc& acc, const Unit& u, int wr, int wc, int fr, int fq) const {
        const int col8 = u.pn * 128 + 32 * wc + 8 * fq;
        EPI_ROWS_BEGIN
            float o[8];
#pragma unroll
            for (int j = 0; j < 4; ++j) { o[j] = acc[ai][0][m][0][j] * fast_sigmoid(acc[ai][1][m][0][j]); o[4 + j] = acc[ai][0][m][1][j] * fast_sigmoid(acc[ai][1][m][1][j]); }
            *(u32x4*)(y + ((size_t)u.pm * 256 + tr) * D + col8) = (u32x4){cvt_pk_bf16(o[0], o[1]), cvt_pk_bf16(o[2], o[3]), cvt_pk_bf16(o[4], o[5]), cvt_pk_bf16(o[6], o[7])};
        EPI_ROWS_END
    }
};
struct SchedMoe {
    pg8::Order o; const bf16_t* A; const bf16_t* W; int lda; int ldb; int nrows_e;
    const LAS int* tile_e; int nt;
    __device__ __forceinline__ int ktiles(const Unit&) const { return nt; }
    __device__ __forceinline__ bool next(int i, Unit& u) const { return o.next(i, u); }
    __device__ __forceinline__ const char* aptr(const Unit& u) const { return (const char*)(A + (size_t)u.pm * 256 * lda); }
    __device__ __forceinline__ const char* bptr(const Unit& u) const { return (const char*)(W + ((size_t)tile_e[u.pm] * nrows_e + (size_t)u.pn * 256) * ldb); }
};
struct EpiBf16Store {
    bf16_t* O; int ldo;
    __device__ __forceinline__ void operator()(const Acc& acc, const Unit& u, int wr, int wc, int fr, int fq) const {
        EPI_ROWS_BEGIN
            const size_t row = (size_t)u.pm * 256 + tr;
#pragma unroll
            for (int bj = 0; bj < 2; ++bj) { const int col8 = u.pn * 256 + 128 * bj + 32 * wc + 8 * fq; const f32x4 v0 = acc[ai][bj][m][0], v1 = acc[ai][bj][m][1];
                *(u32x4*)(O + row * ldo + col8) = (u32x4){cvt_pk_bf16(v0[0], v0[1]), cvt_pk_bf16(v0[2], v0[3]), cvt_pk_bf16(v1[0], v1[1]), cvt_pk_bf16(v1[2], v1[3])}; }
        EPI_ROWS_END
    }
};
struct SchedCtxSplit {
    pg8::Order o; const bf16_t* A; const bf16_t* Bt; int lda, ldb, ntfull, S, G, c;
    __device__ __forceinline__ bool next(int i, Unit& u) const {
        const int L = i * G + c;
        if (L < 256) { o.map(L, u); return true; }
        const int j = L - 256; if (j >= 16 * S) return false;
        const int t = j / S; u.ks = j % S; u.pm = 64 + (t >> 2); u.pn = t & 3; return true; }
    __device__ __forceinline__ int ktiles(const Unit& u) const { return u.ks < 0 ? ntfull : ntfull / S; }
    __device__ __forceinline__ const char* aptr(const Unit& u) const { return (const char*)(A + (size_t)u.pm * 256 * lda + (u.ks < 0 ? 0 : u.ks * (ntfull / S) * 64)); }
    __device__ __forceinline__ const char* bptr(const Unit& u) const { return (const char*)(Bt + (size_t)u.pn * 256 * ldb + (u.ks < 0 ? 0 : u.ks * (ntfull / S) * 64)); }
};
struct EpiBf16OrPart {
    bf16_t* O; int ldo; float* part; int row0, nrows;
    __device__ __forceinline__ void operator()(const Acc& acc, const Unit& u, int wr, int wc, int fr, int fq) const {
        EPI_ROWS_BEGIN
            const size_t row = (size_t)u.pm * 256 + tr;
#pragma unroll
            for (int bj = 0; bj < 2; ++bj) { const int col8 = u.pn * 256 + 128 * bj + 32 * wc + 8 * fq; const f32x4 v0 = acc[ai][bj][m][0], v1 = acc[ai][bj][m][1];
                if (u.ks < 0) *(u32x4*)(O + row * ldo + col8) = (u32x4){cvt_pk_bf16(v0[0], v0[1]), cvt_pk_bf16(v0[2], v0[3]), cvt_pk_bf16(v1[0], v1[1]), cvt_pk_bf16(v1[2], v1[3])};
                else { float* pp = part + ((size_t)u.ks * nrows + (row - row0)) * D + col8; *(f32x4*)pp = v0; *(f32x4*)(pp + 4) = v1; } }
        EPI_ROWS_END
    }
};
struct SchedMoeD {
    pg8::Order o; const bf16_t* A; const bf16_t* W; int lda, ldb, ntfull, S, G, c, RT, NT; const LAS int* tile_e;
    __device__ __forceinline__ bool next(int i, Unit& u) const {
        const int L = i * G + c;
        if (L < RT * 4) { o.map(L, u); return true; }
        const int j = L - RT * 4; if (j >= (NT - RT) * 4 * S) return false;
        const int t = j / S; u.ks = (S > 1) ? j % S : -1; u.pm = RT + (t >> 2); u.pn = t & 3; return true; }
    __device__ __forceinline__ int ktiles(const Unit& u) const { return u.ks < 0 ? ntfull : ntfull / S; }
    __device__ __forceinline__ const char* aptr(const Unit& u) const { return (const char*)(A + (size_t)u.pm * 256 * lda + (u.ks < 0 ? 0 : u.ks * (ntfull / S) * 64)); }
    __device__ __forceinline__ const char* bptr(const Unit& u) const { return (const char*)(W + ((size_t)tile_e[u.pm] * 1024 + (size_t)u.pn * 256) * ldb + (u.ks < 0 ? 0 : u.ks * (ntfull / S) * 64)); }
};
__device__ __forceinline__ void moe_split_plan(int NT, int G, int& RT, int& S) {
    RT = ((NT * 4) / G) * G / 4; const int rem = (NT - RT) * 4; S = (rem > 0 && rem * 7 <= G) ? 7 : ((rem > 0 && rem * 4 <= G) ? 4 : ((rem > 0 && rem * 2 <= G) ? 2 : 1));
    if (RT == 0) { RT = NT; S = 1; }
}
}
namespace fp {
template <int DQK> struct AttnCfg { static constexpr int KP = 2 * DQK + 16, KBYTES = 64 * KP, VBYTES = 8192, BUF = KBYTES + VBYTES, CK = DQK / 8, NKCH = 64 * CK; };
struct AttnArgs {
    const bf16_t* Q; int qp; const bf16_t* K; int kp; const bf16_t* V; int vp; bf16_t* O; int op;
    int qrow0;
    int k0row, nt0;
    int k1row, nt1;
    int gr0, krow0, window;
};
__device__ __forceinline__ int crow(int r, int hi) { return (r & 3) + 8 * (r >> 2) + 4 * hi; }
__device__ __forceinline__ s16x4 ds_tr(LAS const unsigned char* p) { typedef short v4i16_t __attribute__((ext_vector_type(4))); return __builtin_bit_cast(s16x4, __builtin_amdgcn_ds_read_tr16_b64_v4i16((LAS v4i16_t*)p)); }

__device__ __forceinline__ void glds16(const void* gsrc, unsigned lds_dst) { unsigned keep;
    asm volatile("s_mov_b32 %0, m0\n\ts_mov_b32 m0, %2\n\ts_nop 0\n\tglobal_load_lds_dwordx4 %1, off\n\ts_mov_b32 m0, %0" : "=&s"(keep) : "v"(gsrc), "s"(lds_dst) : "memory"); }
__device__ __forceinline__ float max3f(float a, float b, float c) { float r; asm("v_max3_f32 %0, %1, %2, %3" : "=v"(r) : "v"(a), "v"(b), "v"(c)); return r; }
template <int DQK, bool NAW, bool DEFER>
__device__ __forceinline__ void attn_body(LAS unsigned char* lds, const AttnArgs& A, const LAS float* bias) {
    typedef AttnCfg<DQK> C;
    constexpr int VOFF = 2 * C::KBYTES;
    const int tid = threadIdx.x, lane = tid & 63, w = __builtin_amdgcn_readfirstlane(tid >> 6), q = lane & 31, hi = lane >> 5;
    constexpr int ND = DQK / 16;
    bf16x8 qf[ND];
    { const bf16_t* qr = A.Q + (size_t)(A.qrow0 + 32 * w + q) * A.qp + 8 * hi;
#pragma unroll
      for (int d0 = 0; d0 < ND; ++d0) qf[d0] = *(const bf16x8*)(qr + 16 * d0); }
    const int NT = A.nt0 + A.nt1;
    const int kid0 = tid, kid1 = tid + 512; const bool has1 = kid1 < C::NKCH;
    const int kr0 = kid0 / C::CK, kc0 = kid0 % C::CK, kr1 = kid1 / C::CK, kc1 = kid1 % C::CK, vr = tid >> 3, vc = tid & 7;
    const unsigned kl0 = kr0 * C::KP + kc0 * 16, kl1 = kr1 * C::KP + kc1 * 16, vl = VOFF + (vc >> 2) * 4096 + vr * 64 + (vc & 3) * 16;
    u32x4 rk0, rk1, rv; rk1 = (u32x4){0u, 0u, 0u, 0u};
#define ATT_LOAD(t) do { const int rb_ = (t) < A.nt0 ? A.k0row + 64 * (t) : A.k1row + 64 * ((t) - A.nt0); \
        rk0 = *(const u32x4*)(A.K + (size_t)(rb_ + kr0) * A.kp + kc0 * 8); if (has1) rk1 = *(const u32x4*)(A.K + (size_t)(rb_ + kr1) * A.kp + kc1 * 8); \
        rv = *(const u32x4*)(A.V + (size_t)(rb_ + vr) * A.vp + vc * 8); } while (0)
#define ATT_WRITE(kslot, vslot) do { *(LAS u32x4*)(lds + (kslot) * C::KBYTES + kl0) = rk0; if (has1) *(LAS u32x4*)(lds + (kslot) * C::KBYTES + kl1) = rk1; *(LAS u32x4*)(lds + (vslot) * C::VBYTES + vl) = rv; } while (0)
    ATT_LOAD(0);
    __syncthreads();
    ATT_WRITE(0, 0);
    __syncthreads();
    float mrow = 0.f, lrow = 0.f; f32x16 o0 = {}, o1 = {}; f32x16 negm = {}; bool first = true;
    constexpr float THR = 8.f;
    const int gr = A.gr0 + (w >> 1), cq = 32 * (w & 1) + q;
    int rs = gr - 4; rs = rs < 0 ? 0 : (rs > 56 ? 56 : rs); int csq = cq - 8; csq = csq < 0 ? 0 : (csq > 48 ? 48 : csq);
    const int i16 = lane & 15, tq = i16 >> 2, tp = i16 & 3, blk = (lane >> 4) & 1;
    const unsigned voff = VOFF + (4 * hi + tq) * 64 + (16 * blk + 4 * tp) * 2;
    bf16x8 pb[2][2]; bool pend = false; int vs_prev = 0, vs_cur = 0, vs_next = 1;
#define ATT_PV(vslot) do { _Pragma("unroll") for (int kh = 0; kh < 2; ++kh) _Pragma("unroll") for (int s = 0; s < 2; ++s) { \
            LAS const unsigned char* vb = lds + (vslot) * C::VBYTES + voff + (32 * kh + 16 * s) * 64; \
            const s16x4 a0 = ds_tr(vb), a1 = ds_tr(vb + 8 * 64), c0 = ds_tr(vb + 4096), c1 = ds_tr(vb + 4096 + 8 * 64); \
            const bf16x8 va = (bf16x8){a0[0], a0[1], a0[2], a0[3], a1[0], a1[1], a1[2], a1[3]}, vc2 = (bf16x8){c0[0], c0[1], c0[2], c0[3], c1[0], c1[1], c1[2], c1[3]}; \
            o0 = __builtin_amdgcn_mfma_f32_32x32x16_bf16(va, pb[kh][s], o0, 0, 0, 0); \
            o1 = __builtin_amdgcn_mfma_f32_32x32x16_bf16(vc2, pb[kh][s], o1, 0, 0, 0); } } while (0)
    for (int t = 0; t < NT; ++t) {
        const int b = t & 1;
        if (t + 1 < NT) ATT_LOAD(t + 1);
        if (DEFER) { if (pend) { ATT_PV(vs_prev); pend = false; } }
        bool active = true; int krow = 0;
        if (NAW) { if (A.window && t < A.nt0) { krow = A.krow0 + t; active = (krow >= rs) && (krow < rs + 8); } }
        if (active) {
            LAS const unsigned char* kb = lds + b * C::KBYTES;
            f32x16 p0, p1;
#pragma unroll
            for (int d0 = 0; d0 < ND; ++d0) {
                const bf16x8 k0 = *(LAS const bf16x8*)(kb + q * C::KP + (16 * d0 + 8 * hi) * 2);
                const bf16x8 k1 = *(LAS const bf16x8*)(kb + (32 + q) * C::KP + (16 * d0 + 8 * hi) * 2);
                if (d0 == 0) { p0 = __builtin_amdgcn_mfma_f32_32x32x16_bf16(k0, qf[0], negm, 0, 0, 0); p1 = __builtin_amdgcn_mfma_f32_32x32x16_bf16(k1, qf[0], negm, 0, 0, 0); }
                else { p0 = __builtin_amdgcn_mfma_f32_32x32x16_bf16(k0, qf[d0], p0, 0, 0, 0); p1 = __builtin_amdgcn_mfma_f32_32x32x16_bf16(k1, qf[d0], p1, 0, 0, 0); }
            }
            if (NAW) { if (A.window && t < A.nt0) {
                const LAS float* brow = bias + (krow - gr + 7) * 31;
#pragma unroll
                for (int r = 0; r < 16; ++r) { const int ck0 = crow(r, hi), ck1 = 32 + ck0;
                    { const int dc = ck0 - csq; int bi = ck0 - cq + 15; bi = bi < 0 ? 0 : (bi > 30 ? 30 : bi); p0[r] = ((unsigned)dc < 16u) ? p0[r] + brow[bi] : -INFINITY; }
                    { const int dc = ck1 - csq; int bi = ck1 - cq + 15; bi = bi < 0 ? 0 : (bi > 30 ? 30 : bi); p1[r] = ((unsigned)dc < 16u) ? p1[r] + brow[bi] : -INFINITY; } }
            } }
            float ra = max3f(p0[0], p0[1], p1[0]), rb2 = max3f(p0[2], p0[3], p1[1]); ra = max3f(ra, p1[2], p1[3]);
#pragma unroll
            for (int r = 4; r < 16; r += 4) { ra = max3f(ra, p0[r], p0[r + 1]); rb2 = max3f(rb2, p0[r + 2], p0[r + 3]); ra = max3f(ra, p1[r], p1[r + 1]); rb2 = max3f(rb2, p1[r + 2], p1[r + 3]); }
            float rm = max3f(ra, rb2, rb2);
            { auto rr = __builtin_amdgcn_permlane32_swap(__float_as_uint(rm), __float_as_uint(rm), false, false); rm = max3f(__uint_as_float(rr[0]), __uint_as_float(rr[1]), __uint_as_float(rr[1])); }
            if (first || __any(rm > THR)) {
                const float delta = first ? rm : fmaxf(rm, 0.f), alpha = first ? 0.f : __builtin_amdgcn_exp2f(-delta);
                mrow += delta; lrow *= alpha;
#pragma unroll
                for (int r = 0; r < 16; ++r) { p0[r] -= delta; p1[r] -= delta; o0[r] *= alpha; o1[r] *= alpha; negm[r] = -mrow; }
                first = false;
            }
            float ls = 0.f;
#pragma unroll
            for (int r = 0; r < 16; ++r) { p0[r] = __builtin_amdgcn_exp2f(p0[r]); p1[r] = __builtin_amdgcn_exp2f(p1[r]); ls += p0[r] + p1[r]; }
            lrow += ls;
#pragma unroll
            for (int s = 0; s < 2; ++s) {
                pb[0][s] = __builtin_bit_cast(bf16x8, (u32x4){cvt_pk_bf16(p0[8 * s], p0[8 * s + 1]), cvt_pk_bf16(p0[8 * s + 2], p0[8 * s + 3]), cvt_pk_bf16(p0[8 * s + 4], p0[8 * s + 5]), cvt_pk_bf16(p0[8 * s + 6], p0[8 * s + 7])});
                pb[1][s] = __builtin_bit_cast(bf16x8, (u32x4){cvt_pk_bf16(p1[8 * s], p1[8 * s + 1]), cvt_pk_bf16(p1[8 * s + 2], p1[8 * s + 3]), cvt_pk_bf16(p1[8 * s + 4], p1[8 * s + 5]), cvt_pk_bf16(p1[8 * s + 6], p1[8 * s + 7])});
            }
            if (DEFER) pend = true; else ATT_PV(vs_cur);
        }
        if (t + 1 < NT) ATT_WRITE(b ^ 1, vs_next);
        __syncthreads();
        vs_prev = vs_cur; vs_cur = vs_next; vs_next = (vs_next == 2) ? 0 : vs_next + 1;
    }
    if (DEFER) { if (pend) ATT_PV(vs_prev); }
#undef ATT_PV
#undef ATT_LOAD
#undef ATT_WRITE
    { auto rr = __builtin_amdgcn_permlane32_swap(__float_as_uint(lrow), __float_as_uint(lrow), false, false); lrow = __uint_as_float(rr[0]) + __uint_as_float(rr[1]); }
    const float inv = 1.f / lrow;
    bf16_t* orow = A.O + (size_t)(A.qrow0 + 32 * w + q) * A.op;
#pragma unroll
    for (int rg = 0; rg < 4; ++rg) {
        *(u32x2*)(orow + 8 * rg + 4 * hi) = (u32x2){cvt_pk_bf16(o0[4 * rg] * inv, o0[4 * rg + 1] * inv), cvt_pk_bf16(o0[4 * rg + 2] * inv, o0[4 * rg + 3] * inv)};
        *(u32x2*)(orow + 32 + 8 * rg + 4 * hi) = (u32x2){cvt_pk_bf16(o1[4 * rg] * inv, o1[4 * rg + 1] * inv), cvt_pk_bf16(o1[4 * rg + 2] * inv, o1[4 * rg + 3] * inv)};
    }
}
template <int DQK, bool NAW>
__device__ __forceinline__ void attn_unit(LAS unsigned char* lds, const AttnArgs& A, const LAS float* bias) {
    if (__builtin_amdgcn_readfirstlane(threadIdx.x >> 8) == 0) attn_body<DQK, NAW, false>(lds, A, bias); else attn_body<DQK, NAW, true>(lds, A, bias);
}

__device__ __forceinline__ void p4_attention(Frame& F) {
    unsigned char* ws = F.ws; const Args& a = *F.a;
    const bf16_t* P = (const bf16_t*)(ws + WS_P); const bf16_t* Qb = (const bf16_t*)(ws + WS_Q); const bf16_t* Kf = (const bf16_t*)(ws + WS_KF); const bf16_t* Vb = (const bf16_t*)(ws + WS_V); bf16_t* AO = (bf16_t*)(ws + WS_AO);
#ifndef PROBE_PH
#define PROBE_PH -1
#endif
    for (int ii = 0; ii < ((PROBE_PH == 40) ? 5 : 3); ++ii) { const int i = (PROBE_PH == 40 && ii >= 3) ? ii - 3 : ii;
        AttnArgs A; A.gr0 = 0; A.krow0 = 0; A.window = 0;
        if (i < 2) { const int u = F.vcu * 2 + i; if (u >= 512) break; const int bh = u >> 4, qb = u & 15, b = bh >> 3, h = bh & 7;
            A.Q = Qb + h * 96; A.qp = 768; A.K = Kf + h * 96; A.kp = 768; A.V = Vb + h * 64; A.vp = 512; A.O = AO + h * 64; A.op = D;
            A.qrow0 = b * SEQ + qb * 256; A.k0row = b * SEQ; A.nt0 = SEQ / 64; A.k1row = ML + b * CTX; A.nt1 = CTX / 64; }
        else { if (F.vcu >= 32) break; const int b = F.vcu >> 3, h = F.vcu & 7;
            A.Q = Qb + h * 96; A.qp = 768; A.K = Kf + h * 96; A.kp = 768; A.V = Vb + h * 64; A.vp = 512; A.O = AO + h * 64; A.op = D;
            A.qrow0 = ML + b * CTX; A.k0row = ML + b * CTX; A.nt0 = CTX / 64; A.k1row = 0; A.nt1 = 0; }
        attn_unit<96, false>(F.lds, A, nullptr);
    }
    LAS float* bias = (LAS float*)(F.lds + LDS_BIAS);
    for (int ii = 0; ii < ((PROBE_PH == 41) ? 5 : 3); ++ii) { const int i = (PROBE_PH == 41 && ii >= 3) ? ii - 3 : ii;
        AttnArgs A; int h;
        if (i < 2) { const int u = F.vcu * 2 + i; if (u >= 512) break; const int bh = u >> 4, qb = u & 15, b = bh >> 3; h = bh & 7;
            const int gr0 = 4 * qb; int r0 = gr0 - 4; r0 = r0 < 0 ? 0 : (r0 > 56 ? 56 : r0); int r1 = gr0 + 3 - 4; r1 = r1 < 0 ? 0 : (r1 > 56 ? 56 : r1);
            A.qrow0 = b * SEQ + qb * 256; A.k0row = b * SEQ + r0 * 64; A.nt0 = r1 + 8 - r0; A.k1row = ML + b * CTX; A.nt1 = CTX / 64; A.gr0 = gr0; A.krow0 = r0; A.window = 1; }
        else { if (F.vcu < 32 || F.vcu >= 64) break; const int v = F.vcu - 32, b = v >> 3; h = v & 7;
            A.qrow0 = ML + b * CTX; A.k0row = ML + b * CTX; A.nt0 = CTX / 64; A.k1row = 0; A.nt1 = 0; A.gr0 = 0; A.krow0 = 0; A.window = 0; }
        A.Q = P + 672 + h * 64; A.qp = NIN; A.K = P + 1184 + h * 64; A.kp = NIN; A.V = P + 1696 + h * 64; A.vp = NIN; A.O = AO + 512 + h * 64; A.op = D;
        __syncthreads();
        if (F.tid < 465) bias[F.tid] = a.in[I_rpb][h * 465 + F.tid] * LOG2E;
        attn_unit<64, true>(F.lds, A, bias);
    }
}

__device__ __forceinline__ void p12_scan(Frame& F) {
    unsigned char* ws = F.ws; const Args& a = *F.a;
    const float* sloc = (const float*)(ws + WS_SLOC); bf16_t* acat = (bf16_t*)(ws + WS_ACAT);
    const int gwv = F.vcu * NWAVES + F.wave;
    if (gwv >= NB * 64 * 2) return;
    const int dir = gwv & 1, g = (gwv >> 1) & 63, b = gwv >> 7, p = F.lane;
    const f32x4 dsc = s5_disc(a, g, dir, p); const f32x2 aT = cpow(dsc.x, dsc.y, (float)TCH);
    float sr = 0.f, si = 0.f;
    const float* base = sloc + (size_t)g * 544 * 256 + dir * 128 + p;
    bf16_t* abase = acat + (size_t)g * 512 * SKA + SK + dir * 128 + p;
    {
        float lr[8], li[8];
#pragma unroll
        for (int j = 0; j < 8; ++j) { const int c = dir ? NCHC - 1 - j : j; const size_t R = 512 + b * NCHC + c; lr[j] = base[R * 256]; li[j] = base[R * 256 + 64]; }
#pragma unroll
        for (int j = 0; j < 8; ++j) { const float nr = aT.x * sr - aT.y * si + lr[j], ni = aT.x * si + aT.y * sr + li[j]; sr = nr; si = ni; }
    }
    for (int s0 = 0; s0 < NCH; s0 += 16) {
        float lr[16], li[16];
#pragma unroll
        for (int j = 0; j < 16; ++j) { const int c = dir ? NCH - 1 - (s0 + j) : s0 + j; const size_t R = b * NCH + c; lr[j] = base[R * 256]; li[j] = base[R * 256 + 64]; }
#pragma unroll
        for (int j = 0; j < 16; ++j) { const int c = dir ? NCH - 1 - (s0 + j) : s0 + j; const size_t R = b * NCH + c;
            bf16_t* ap = abase + R * SKA; ap[0] = (bf16_t)f2bf(sr); ap[64] = (bf16_t)f2bf(si);
            const float nr = aT.x * sr - aT.y * si + lr[j], ni = aT.x * si + aT.y * sr + li[j]; sr = nr; si = ni; }
    }
}

__device__ __forceinline__ void moe_tables(Frame& F) {
    LAS int* toff = (LAS int*)(F.lds + LDS_MOE); LAS int* te = toff + 16;
    __syncthreads();
    if (F.tid == 0) { const unsigned* cnt = (const unsigned*)(F.ws + WS_CTL + CTL_CNT); int acc = 0;
        for (int e = 0; e < NE; ++e) { toff[e] = acc; const int n = (int)((__hip_atomic_load(cnt + 64 * e, __ATOMIC_RELAXED, __HIP_MEMORY_SCOPE_AGENT) + 255u) >> 8); for (int j = 0; j < n; ++j) te[acc + j] = e; acc += n; }
        toff[NE] = acc; }
    __syncthreads();
}
__device__ __forceinline__ void p15_route_gather(Frame& F) {
    unsigned char* ws = F.ws; const Args& a = *F.a; const int lane = F.lane;
    const float* mp1 = (const float*)(ws + WS_MODP) + 5 * 6144;
    LAS int* lcnt = (LAS int*)(F.lds + LDS_BIAS);
    LAS int* lrec = lcnt + 16;
    LAS float* lw = (LAS float*)(lrec + 256);
    LAS int* toff = (LAS int*)(F.lds + LDS_MOE); LAS int* te = toff + 16;
    if (F.tid < 16) lcnt[F.tid] = 0;
    __syncthreads();
    int* tok_r = (int*)(ws + WS_TOK); float* tok_w = (float*)(ws + WS_TOK + (size_t)ML * 8);
    f32x4 rw0[16], rw1[16];
#pragma unroll
    for (int j = 0; j < 4; ++j)
#pragma unroll
        for (int c = 0; c < 4; ++c) { const int k = 4 * (lane + 64 * j) + c; rw0[4 * j + c] = *(const f32x4*)(a.in[I_router] + (size_t)k * 8); rw1[4 * j + c] = *(const f32x4*)(a.in[I_router] + (size_t)k * 8 + 4); }
    for (int ib = 0; ib < 4; ++ib) {
        const float* xr[2]; const float* sh[2]; const float* sc[2]; bf16_t* orow[2]; f32x4 v[2][4]; int rows[2]; const bf16_t* yr[2]; const float* gt[2]; float* xo[2]; LAS u32x2* lrow[2];
#pragma unroll
        for (int r = 0; r < 2; ++r) { const int row = (F.vcu * NWAVES + F.wave) + (2 * ib + r) * F.G * NWAVES; const bool ok = row < ML; const int rw = ok ? row : 0; rows[r] = ok ? row : -1;
            xr[r] = ok ? a.out + (size_t)rw * D : nullptr; const float* mp = mp1 + (size_t)(rw / SEQ) * 6144; sh[r] = mp + 3 * 1024; sc[r] = mp + 4 * 1024; orow[r] = nullptr;
            yr[r] = (const bf16_t*)(ws + WS_Y3) + (size_t)rw * D; gt[r] = mp + 2 * 1024; xo[r] = a.out + (size_t)rw * D; lrow[r] = (LAS u32x2*)(F.lds + (F.wave * 8 + 2 * ib + r) * 2048); }
        modulate_rows<2, true, true>(xr, yr, gt, xo, a.in[I_n2g] + D, sh, sc, orow, lane, v, lrow);
#pragma unroll
        for (int r = 0; r < 2; ++r) if (rows[r] >= 0) {
            float lg[8] = {0.f, 0.f, 0.f, 0.f, 0.f, 0.f, 0.f, 0.f};
#pragma unroll
            for (int j = 0; j < 4; ++j)
#pragma unroll
                for (int c = 0; c < 4; ++c) { const f32x4 w0 = rw0[4 * j + c], w1 = rw1[4 * j + c]; const float tv = v[r][j][c];
                    lg[0] += tv * w0[0]; lg[1] += tv * w0[1]; lg[2] += tv * w0[2]; lg[3] += tv * w0[3]; lg[4] += tv * w1[0]; lg[5] += tv * w1[1]; lg[6] += tv * w1[2]; lg[7] += tv * w1[3]; }
#pragma unroll
            for (int e = 0; e < 8; ++e) lg[e] = wave_sum(lg[e]);
            if (lane == 0) {
                int i1 = 0; for (int e = 1; e < 8; ++e) if (lg[e] > lg[i1]) i1 = e;
                int i2 = -1; for (int e = 0; e < 8; ++e) if (e != i1 && (i2 < 0 || lg[e] > lg[i2])) i2 = e;
                const float e2 = expf(lg[i2] - lg[i1]), w1 = 1.f / (1.f + e2), w2 = e2 / (1.f + e2);
                const int li = F.wave * 8 + 2 * ib + r;
                lrec[li * 4 + 0] = i1; lrec[li * 4 + 1] = i2; lrec[li * 4 + 2] = __hip_atomic_fetch_add(lcnt + i1, 1, __ATOMIC_RELAXED, __HIP_MEMORY_SCOPE_WORKGROUP); lrec[li * 4 + 3] = __hip_atomic_fetch_add(lcnt + i2, 1, __ATOMIC_RELAXED, __HIP_MEMORY_SCOPE_WORKGROUP);
                lw[li * 2] = w1; lw[li * 2 + 1] = w2;
            }
        }
    }
    __syncthreads();
    unsigned* cnt = (unsigned*)(ws + WS_CTL + CTL_CNT); unsigned* done = (unsigned*)(ws + WS_CTL + CTL_DONE);
    if (F.tid < 8) lcnt[8 + F.tid] = (int)__hip_atomic_fetch_add(cnt + 64 * F.tid, (unsigned)lcnt[F.tid], __ATOMIC_RELAXED, __HIP_MEMORY_SCOPE_AGENT);
    __syncthreads();
    if (F.tid == 0) {
        (void)__hip_atomic_fetch_add(done, 1u, __ATOMIC_RELAXED, __HIP_MEMORY_SCOPE_AGENT);
        unsigned sp = 0; while (__hip_atomic_load(done, __ATOMIC_RELAXED, __HIP_MEMORY_SCOPE_AGENT) < (unsigned)F.G) { __builtin_amdgcn_s_sleep(2); if (++sp > (1u << 20)) break; }
        int acc = 0;
        for (int e = 0; e < NE; ++e) { toff[e] = acc; const int n = (int)((__hip_atomic_load(cnt + 64 * e, __ATOMIC_RELAXED, __HIP_MEMORY_SCOPE_AGENT) + 255u) >> 8); for (int j = 0; j < n; ++j) te[acc + j] = e; acc += n; }
        toff[NE] = acc;
    }
    __syncthreads();
    bf16_t* Xg = (bf16_t*)(ws + WS_XG);
    for (int i = 0; i < 8; ++i) { const int li = F.wave * 8 + i; const int row = (F.vcu * NWAVES + F.wave) + i * F.G * NWAVES; if (row >= ML) continue;
        const int e0 = lrec[li * 4], e1 = lrec[li * 4 + 1]; const size_t r0 = (size_t)toff[e0] * 256 + lcnt[8 + e0] + lrec[li * 4 + 2], r1 = (size_t)toff[e1] * 256 + lcnt[8 + e1] + lrec[li * 4 + 3];
        const LAS u32x4* src = (const LAS u32x4*)(F.lds + li * 2048); const u32x4 x0 = src[lane], x1 = src[lane + 64];
        u32x4* d0 = (u32x4*)(Xg + r0 * D); u32x4* d1 = (u32x4*)(Xg + r1 * D); d0[lane] = x0; d0[lane + 64] = x1; d1[lane] = x0; d1[lane + 64] = x1;
        if (lane == 0) { tok_r[row * 2] = (int)r0; tok_r[row * 2 + 1] = (int)r1; tok_w[row * 2] = lw[li * 2]; tok_w[row * 2 + 1] = lw[li * 2 + 1]; } }
    __syncthreads();
}
__device__ __forceinline__ void p19_final(Frame& F) {
    unsigned char* ws = F.ws; const Args& a = *F.a; const LAS int* toff = (const LAS int*)(F.lds + LDS_MOE); const int lane = F.lane;
    const int* tok_r = (const int*)(ws + WS_TOK); const float* tok_w = (const float*)(ws + WS_TOK + (size_t)ML * 8);
    const bf16_t* Yg = (const bf16_t*)(ws + WS_XG); const float* mp1 = (const float*)(ws + WS_MODP) + 5 * 6144;
    const int NGW = F.G * NWAVES; int RT, SS; moe_split_plan(toff[NE], F.G, RT, SS); const size_t prow0 = (size_t)RT * 256, pn = (size_t)(toff[NE] - RT) * 256;
    const float* part = (const float*)(ws + WS_PART18);
    for (int row0 = F.vcu * NWAVES + F.wave; row0 < ML; row0 += 2 * NGW) {
        f32x4 v[2][4], ya[2][4], yb[2][4]; float w0[2], w1[2]; bool ok[2];
#pragma unroll
        for (int r = 0; r < 2; ++r) { const int row = row0 + r * NGW; ok[r] = row < ML; if (ok[r]) {
            const size_t ra = (size_t)tok_r[row * 2], rb = (size_t)tok_r[row * 2 + 1]; w0[r] = tok_w[row * 2]; w1[r] = tok_w[row * 2 + 1];
#pragma unroll
            for (int j = 0; j < 4; ++j) v[r][j] = ((const f32x4*)(a.out + (size_t)row * D))[lane + 64 * j];
            if (SS > 1 && ra >= prow0) {
#pragma unroll
                for (int j = 0; j < 4; ++j) ya[r][j] = (f32x4){0.f, 0.f, 0.f, 0.f};
                for (int s = 0; s < SS; ++s) { const f32x4* pp = (const f32x4*)(part + ((size_t)s * pn + (ra - prow0)) * D);
#pragma unroll
                    for (int j = 0; j < 4; ++j) ya[r][j] += pp[lane + 64 * j]; }
#pragma unroll
                for (int j = 0; j < 4; ++j) { const unsigned lo = cvt_pk_bf16(ya[r][j].x, ya[r][j].y), hi2 = cvt_pk_bf16(ya[r][j].z, ya[r][j].w); ya[r][j] = (f32x4){bf_lo(lo), bf_hi(lo), bf_lo(hi2), bf_hi(hi2)}; }
            } else {
#pragma unroll
                for (int j = 0; j < 4; ++j) { const u32x2 y = *((const u32x2*)(Yg + ra * D) + lane + 64 * j); ya[r][j] = (f32x4){bf_lo(y.x), bf_hi(y.x), bf_lo(y.y), bf_hi(y.y)}; } }
            if (SS > 1 && rb >= prow0) {
#pragma unroll
                for (int j = 0; j < 4; ++j) yb[r][j] = (f32x4){0.f, 0.f, 0.f, 0.f};
                for (int s = 0; s < SS; ++s) { const f32x4* pp = (const f32x4*)(part + ((size_t)s * pn + (rb - prow0)) * D);
#pragma unroll
                    for (int j = 0; j < 4; ++j) yb[r][j] += pp[lane + 64 * j]; }
#pragma unroll
                for (int j = 0; j < 4; ++j) { const unsigned lo = cvt_pk_bf16(yb[r][j].x, yb[r][j].y), hi2 = cvt_pk_bf16(yb[r][j].z, yb[r][j].w); yb[r][j] = (f32x4){bf_lo(lo), bf_hi(lo), bf_lo(hi2), bf_hi(hi2)}; }
            } else {
#pragma unroll
                for (int j = 0; j < 4; ++j) { const u32x2 y = *((const u32x2*)(Yg + rb * D) + lane + 64 * j); yb[r][j] = (f32x4){bf_lo(y.x), bf_hi(y.x), bf_lo(y.y), bf_hi(y.y)}; } }
        } }
#pragma unroll
        for (int r = 0; r < 2; ++r) if (ok[r]) { const int row = row0 + r * NGW; const float* g2 = mp1 + (size_t)(row / SEQ) * 6144 + 5 * 1024; float* xr = a.out + (size_t)row * D; float ss = 0.f;
#pragma unroll
            for (int j = 0; j < 4; ++j) { const int c4 = lane + 64 * j; const f32x4 gg = ((const f32x4*)g2)[c4];
                v[r][j] = v[r][j] + gg * (w0[r] * ya[r][j] + w1[r] * yb[r][j]); ss += (v[r][j].x * v[r][j].x + v[r][j].y * v[r][j].y) + (v[r][j].z * v[r][j].z + v[r][j].w * v[r][j].w); }
            const float rs = rsqrtf(wave_sum(ss) * (1.f / D) + EPS);
#pragma unroll
            for (int j = 0; j < 4; ++j) { const int c4 = lane + 64 * j; ((f32x4*)xr)[c4] = v[r][j] * rs * ((const f32x4*)a.in[I_fing])[c4]; } }
    }
}
}
namespace fp {
constexpr int NPH = 20;
#ifndef ALIGN17
#define ALIGN17 true
#endif
constexpr int CW_BAR = 4096;
#ifndef TC_Q2
#define TC_Q2 8
#endif
#ifndef TC_Q5
#define TC_Q5 0
#endif
#ifndef TC_Q8
#define TC_Q8 0
#endif
#ifndef TC_Q10
#define TC_Q10 6
#endif
#ifndef TC_Q11
#define TC_Q11 6
#endif
constexpr int TCA = TC_P0, TCB = TCA + 156 * TC_Q2  , TCC = TCB + 240 * TC_Q5  , TCD = TCC + 240 * TC_Q8  , TCE = TCD + 240 * TC_Q10  , TCF = TCE + 64 * TC_Q11  ;

__global__ void __launch_bounds__(NTHR, 2) fwd(Args args) {
    extern __shared__ __attribute__((aligned(16))) unsigned char lds_raw[];
    Frame F;
    F.lds = (LAS unsigned char*)lds_raw; F.tid = threadIdx.x; F.lane = F.tid & 63; F.wave = __builtin_amdgcn_readfirstlane(F.tid >> 6);
    F.G = gridDim.x; { const int bx = blockIdx.x; F.vcu = (F.G % 8 == 0) ? (bx % 8) * (F.G / 8) + bx / 8 : bx; }
    F.a = &args; F.ws = args.ws; F.tailconv = (gridDim.x == 256 && args.ph_lo == 0 && args.ph_hi == NPH) ? 1 : 0;
    unsigned char* ws = args.ws;
    volatile LAS unsigned* MISC = (volatile LAS unsigned*)(F.lds + LDS_MISC);
    if (F.tid < 64) MISC[F.tid] = 0u;
    { LAS f32x2* rope = (LAS f32x2*)(F.lds + LDS_ROPE); const int pos = F.tid >> 3, f = F.tid & 7; const float inv = powf(10000.f, -(float)f * 0.125f), ang = (float)pos * inv; rope[F.tid] = (f32x2){cosf(ang), sinf(ang)}; }
    __syncthreads();
    const int lo = args.ph_lo, hi = args.ph_hi;
    const bool multi = (hi - lo) > 1;
    XcdBarrier bar; bar.bar = (unsigned*)(ws + WS_CTL) + CW_BAR; bar.x = 0; bar.st = MISC;
    if (multi) bar = xcd_barrier_post((unsigned*)(ws + WS_CTL) + CW_BAR, MISC);
#ifndef PH_MASK
#define PH_MASK 0xFFFFF
#endif
#define IN(k) ((((PH_MASK) >> (k)) & 1) && lo <= (k) && (k) < hi)
#ifndef PROBE_PH
#define PROBE_PH -1
#endif
#define RPT(k) for (int rep_ = 0; rep_ < ((PROBE_PH == (k)) ? 2 : 1); ++rep_)
#define SEAM(k) do { if (IN(k) && IN((k) + 1)) xcd_barrier(bar); } while (0)
    const LAS f32x2* rope = (const LAS f32x2*)(F.lds + LDS_ROPE);
    float* modp = (float*)(ws + WS_MODP);
    bf16_t* HB = (bf16_t*)(ws + WS_HB);
    float* XC = (float*)(ws + WS_XC);

    F.wait_adaln = (IN(0) && IN(1)) ? 1 : 0;
    if (IN(0)) RPT(0) { p0_prologue(F, rep_); }
    if (IN(0) && IN(1)) { if (!F.tailconv) xcd_barrier(bar); else __syncthreads(); }
    if (IN(1)) RPT(1) { p1_phase(F); } SEAM(1);
    if (IN(2)) { constexpr int REP_ = (PROBE_PH == 2) ? 2 : 1;
        SchedPlain S; S.o.init(MT / 256, NIN / 256, F.G, (int)blockIdx.x, REP_); S.A = HB; S.Bt = (const bf16_t*)(ws + WS_WIN0); S.lda = D; S.ldb = D; S.nt = D / 64;
        EpiInProj E{(bf16_t*)(ws + WS_P), (float*)(ws + WS_SSQ), (bf16_t*)(ws + WS_KF), rope};
        pg8::gemm_phase<EpiInProj, SchedPlain>(F.lds, D, D, D, S, E);
        if (F.tailconv && (int)blockIdx.x >= 100 && REP_ == 1) tail_convert(F, TCA, TCB, (int)blockIdx.x - 100, 156);
    } SEAM(2);
    if (IN(3)) { constexpr int REP_ = (PROBE_PH == 3) ? 2 : 1;
#ifndef NO_QB
        { SchedPlain S; S.o.init(MT / 256, 768 / 256, F.G, (int)blockIdx.x, REP_); S.A = (const bf16_t*)(ws + WS_P); S.Bt = (const bf16_t*)(ws + WS_WQB); S.lda = NIN; S.ldb = 384; S.nt = 384 / 64;
          EpiQb E{(bf16_t*)(ws + WS_Q), (const float*)(ws + WS_SSQ), rope};
          pg8::gemm_phase<EpiQb, SchedPlain>(F.lds, 384, NIN, 384, S, E); }
#endif
#ifndef NO_KVB
        { SchedPlain S; S.o.init(MT / 256, 1024 / 256, F.G, (int)blockIdx.x, REP_); S.A = (const bf16_t*)(ws + WS_P) + 384; S.Bt = (const bf16_t*)(ws + WS_WKVB); S.lda = NIN; S.ldb = 256; S.nt = 256 / 64;
          EpiKvb E{(bf16_t*)(ws + WS_KF), (bf16_t*)(ws + WS_V), (const float*)(ws + WS_SSQ)};
          pg8::gemm_phase<EpiKvb, SchedPlain>(F.lds, 256, NIN, 256, S, E); }
#endif
    } SEAM(3);
    if (IN(4)) RPT(4) { p4_attention(F); } SEAM(4);
    if (IN(5)) { constexpr int REP_ = 1;
        SchedCtxSplit S; S.o.init(64, 4, F.G, (int)blockIdx.x, 1); S.A = (const bf16_t*)(ws + WS_AO); S.Bt = (const bf16_t*)(ws + WS_WOUT); S.lda = D; S.ldb = D; S.ntfull = D / 64; S.S = 4; S.G = F.G; S.c = (int)blockIdx.x;
        EpiBf16OrPart E{(bf16_t*)(ws + WS_Y1), D, (float*)(ws + WS_PART5), ML, MC};
        pg8::gemm_phase<EpiBf16OrPart, SchedCtxSplit>(F.lds, D, D, D, S, E); (void)REP_;
    } SEAM(5);
    if (IN(6)) RPT(6) {
        const int NGW = F.G * NWAVES; const bf16_t* Y1 = (const bf16_t*)(ws + WS_Y1);
        { const int r = F.vcu * NWAVES + F.wave; if (r < MC) { const float* mp = modp + 4 * 6144;
            ctx_row_part(args.in[I_ctx] + (size_t)r * D, XC + (size_t)r * D, (const float*)(ws + WS_PART5), 4, r, mp + 2 * 1024, args.in[I_n2g], mp + 3 * 1024, mp + 4 * 1024, HB + (size_t)(ML + r) * D, F.lane); } }
        for (int row0 = F.vcu * NWAVES + F.wave; row0 < ML; row0 += 3 * NGW) {
            const float* xr[3]; const bf16_t* yr[3]; const float* gt[3]; float* xo[3]; const float* sh[3]; const float* sc[3]; bf16_t* orow[3]; f32x4 v[3][4];
#pragma unroll
            for (int r = 0; r < 3; ++r) { const int row = row0 + r * NGW; const bool ok = row < ML; const int rw = ok ? row : 0;
                xr[r] = ok ? (rw < ML ? args.in[I_x] + (size_t)rw * D : args.in[I_ctx] + (size_t)(rw - ML) * D) : nullptr; yr[r] = Y1 + (size_t)rw * D; xo[r] = (float*)xrow_ptr(F, rw);
                const float* mp = modp + (size_t)cond_of_row(rw) * 6144; gt[r] = mp + 2 * 1024; sh[r] = mp + 3 * 1024; sc[r] = mp + 4 * 1024; orow[r] = HB + (size_t)rw * D; }
            modulate_rows<3, true>(xr, yr, gt, xo, args.in[I_n2g], sh, sc, orow, F.lane, v); }
    } SEAM(6);
    if (IN(7)) { constexpr int REP_ = (PROBE_PH == 7) ? 2 : 1;
        SchedPlain S; S.o.init(MT / 256, 5632 / 256, F.G, (int)blockIdx.x, REP_); S.A = HB; S.Bt = (const bf16_t*)(ws + WS_WFGU); S.lda = D; S.ldb = D; S.nt = D / 64;
        EpiSwiglu E{(bf16_t*)(ws + WS_HF), LDF, 22, (unsigned)((size_t)MT * LDF * 2)};
        pg8::gemm_phase<EpiSwiglu, SchedPlain, ALIGN17>(F.lds, D, D, D, S, E);
    } SEAM(7);
    if (IN(8)) { constexpr int REP_ = 1;
        SchedCtxSplit S; S.o.init(64, 4, F.G, (int)blockIdx.x, 1); S.A = (const bf16_t*)(ws + WS_HF); S.Bt = (const bf16_t*)(ws + WS_WFD); S.lda = LDF; S.ldb = LDF; S.ntfull = DFF / 64; S.S = 11; S.G = F.G; S.c = (int)blockIdx.x;
        EpiBf16OrPart E{(bf16_t*)(ws + WS_Y2), D, (float*)(ws + WS_PART8), ML, MC};
        pg8::gemm_phase<EpiBf16OrPart, SchedCtxSplit>(F.lds, DFF, LDF, LDF, S, E); (void)REP_;
    } SEAM(8);
    if (IN(9)) RPT(9) {
        const int NGW = F.G * NWAVES; const bf16_t* Y2 = (const bf16_t*)(ws + WS_Y2);
        { const int r = F.vcu * NWAVES + F.wave; if (r < MC) { const float* mp0 = modp + 4 * 6144; const float* mp = mp0 + 5 * 6144;
            ctx_row_part(XC + (size_t)r * D, XC + (size_t)r * D, (const float*)(ws + WS_PART8), 11, r, mp0 + 5 * 1024, args.in[I_n1g] + D, mp, mp + 1024, HB + (size_t)(ML + r) * D, F.lane); } }
        for (int row0 = F.vcu * NWAVES + F.wave; row0 < ML; row0 += 3 * NGW) {
            const float* xr[3]; const bf16_t* yr[3]; const float* gt[3]; float* xo[3]; const float* sh[3]; const float* sc[3]; bf16_t* orow[3]; f32x4 v[3][4];
#pragma unroll
            for (int r = 0; r < 3; ++r) { const int row = row0 + r * NGW; const bool ok = row < ML; const int rw = ok ? row : 0;
                xr[r] = ok ? xrow_ptr(F, rw) : nullptr; yr[r] = Y2 + (size_t)rw * D; xo[r] = (float*)xrow_ptr(F, rw);
                const float* mp0 = modp + (size_t)cond_of_row(rw) * 6144; const float* mp = mp0 + 5 * 6144; gt[r] = mp0 + 5 * 1024; sh[r] = mp; sc[r] = mp + 1024; orow[r] = HB + (size_t)rw * D; }
            modulate_rows<3, true>(xr, yr, gt, xo, args.in[I_n1g] + D, sh, sc, orow, F.lane, v); }
    } SEAM(9);
    if (IN(10)) { constexpr int REP_ = (PROBE_PH == 10) ? 2 : 1;
        SchedPlain S; S.o.init(MT / 256, D / 256, F.G, (int)blockIdx.x, REP_); S.A = HB; S.Bt = (const bf16_t*)(ws + WS_WS5); S.lda = D; S.ldb = D; S.nt = D / 64;
        EpiS5In E{(bf16_t*)(ws + WS_ACAT), (bf16_t*)(ws + WS_ACATC)};
        pg8::gemm_phase<EpiS5In, SchedPlain>(F.lds, D, D, D, S, E);
        if (F.tailconv && (int)blockIdx.x >= 16 && REP_ == 1) tail_convert(F, TCD, TCE, (int)blockIdx.x - 16, 240);
    } SEAM(10);
    if (IN(11)) { constexpr int REP_ = (PROBE_PH == 11) ? 2 : 1;
        SchedSloc S; S.o.init(64 * 3, 1, F.G, (int)blockIdx.x, REP_); S.acat = (const bf16_t*)(ws + WS_ACAT); S.acatc = (const bf16_t*)(ws + WS_ACATC); S.bhat = (const bf16_t*)(ws + WS_BHAT);
        EpiSloc E{(float*)(ws + WS_SLOC)};
        pg8::gemm_phase<EpiSloc, SchedSloc>(F.lds, SK, SKA, SK, S, E);
        if (F.tailconv && (int)blockIdx.x >= 192 && REP_ == 1) tail_convert(F, TCE, TCF, (int)blockIdx.x - 192, 64);
    } SEAM(11);
    if (IN(12)) RPT(12) { p12_scan(F); if (F.tailconv && F.vcu >= 64 && rep_ == 0) { lt_expand(F, (F.vcu - 64) * NWAVES + F.wave, 192 * NWAVES); tail_convert(F, TCF, TC_CHUNKS, F.vcu - 64, 192); } } SEAM(12);
    if (IN(13)) { constexpr int REP_ = (PROBE_PH == 13) ? 2 : 1;
        SchedS5Out S; S.o.init(64 * 2, 2, F.G, (int)blockIdx.x, REP_); S.acat = (const bf16_t*)(ws + WS_ACAT); S.lt = (const bf16_t*)(ws + WS_LT);
        EpiS5Out E{(const bf16_t*)(ws + WS_ACAT), args.in[I_odd], (bf16_t*)(ws + WS_GB)};
        pg8::gemm_phase<EpiS5Out, SchedS5Out>(F.lds, SKA, SKA, SKA, S, E);
    } SEAM(13);
    if (IN(14)) { constexpr int REP_ = (PROBE_PH == 14) ? 2 : 1;
        SchedPlain S; S.o.init(ML / 256, 2048 / 256, F.G, (int)blockIdx.x, REP_); S.A = (const bf16_t*)(ws + WS_GB); S.Bt = (const bf16_t*)(ws + WS_WGLU); S.lda = D; S.ldb = D; S.nt = D / 64;
        EpiGlu E{(bf16_t*)(ws + WS_Y3)};
        pg8::gemm_phase<EpiGlu, SchedPlain>(F.lds, D, D, D, S, E);
    } SEAM(14);
    if (IN(15)) RPT(15) { p15_route_gather(F); }
    if (IN(15) && IN(17)) xcd_barrier(bar);
    if (IN(17)) { constexpr int REP_ = (PROBE_PH == 17) ? 2 : 1;
        if (!IN(15)) moe_tables(F);
        const LAS int* toff = (const LAS int*)(F.lds + LDS_MOE);
        SchedMoe S; S.o.init(toff[NE], 28, F.G, (int)blockIdx.x, REP_); S.A = (const bf16_t*)(ws + WS_XG); S.W = (const bf16_t*)(ws + WS_WMOE_GU); S.lda = D; S.ldb = D; S.nrows_e = 7168; S.tile_e = toff + 16; S.nt = D / 64;
        EpiSwiglu E{(bf16_t*)(ws + WS_HM), DFE, 28, (unsigned)((size_t)MOE_ROWS * DFE * 2)};
#ifndef STAG17
#define STAG17 0
#endif
        if (STAG17) { const int units = toff[NE] * 28, rem = units % F.G;
            if (rem > 0 && (int)blockIdx.x >= rem) { const int k = ((int)blockIdx.x & 3) + 1; for (int i = 0; i < k * STAG17; ++i) __builtin_amdgcn_s_sleep(127); } }
        pg8::gemm_phase<EpiSwiglu, SchedMoe, ALIGN17>(F.lds, D, D, D, S, E);
    } SEAM(17);
    if (IN(18)) { constexpr int REP_ = (PROBE_PH == 18) ? 2 : 1;
        if (!IN(17)) moe_tables(F);
        const LAS int* toff = (const LAS int*)(F.lds + LDS_MOE);
        const int NT = toff[NE]; int RT, SS; moe_split_plan(NT, F.G, RT, SS);
        SchedMoeD S; S.o.init(RT, 4, F.G, (int)blockIdx.x, 1); S.A = (const bf16_t*)(ws + WS_HM); S.W = (const bf16_t*)(ws + WS_WMOE_D); S.lda = DFE; S.ldb = DFE; S.ntfull = DFE / 64; S.S = SS; S.G = F.G; S.c = (int)blockIdx.x; S.RT = RT; S.NT = NT; S.tile_e = toff + 16;
        EpiBf16OrPart E{(bf16_t*)(ws + WS_XG), D, (float*)(ws + WS_PART18), RT * 256, (NT - RT) * 256};
        pg8::gemm_phase<EpiBf16OrPart, SchedMoeD>(F.lds, DFE, DFE, DFE, S, E); (void)REP_;
    } SEAM(18);
    if (IN(19)) RPT(19) { if (!IN(18)) moe_tables(F); p19_final(F); }
#undef IN
#undef SEAM
}

inline void launch_range(const Args& base, int lo, int hi, int grid, hipStream_t stream, bool zero_bar) {
    Args a = base; a.ph_lo = lo; a.ph_hi = hi;
    if (zero_bar && hi - lo > 1) (void)hipMemsetAsync(a.ws + WS_CTL + (size_t)CW_BAR * 4, 0, XCD_BAR_WORDS * 4, stream);
    hipLaunchKernelGGL(fwd, dim3(grid), dim3(NTHR), LDS_BYTES, stream, a);
    const hipError_t le = hipPeekAtLastError();
    if (le != hipSuccess) fprintf(stderr, "kernel_launch: launch [%d,%d) failed: %s\n", lo, hi, hipGetErrorName(le));
}
}

#ifndef DBG_MODE
#define DBG_MODE 0
#endif
#ifndef PER_PHASE
#define PER_PHASE 0
#endif
extern "C" void kernel_launch(void* const* d_in, const int* in_sizes, int n_in, void* d_out, int out_size, void* d_ws, size_t ws_size, hipStream_t stream) {
    (void)in_sizes; (void)out_size;
    static int grid = 0;
    if (grid == 0) {
        int dev = 0, cus = 0;
        if (n_in != 33 || ws_size < fp::WS_END || hipGetDevice(&dev) != hipSuccess || hipDeviceGetAttribute(&cus, hipDeviceAttributeMultiprocessorCount, dev) != hipSuccess) { fprintf(stderr, "kernel_launch: bad setup (n_in %d ws %zu)\n", n_in, ws_size); grid = -1; return; }
        if (hipFuncSetAttribute((const void*)fp::fwd, hipFuncAttributeMaxDynamicSharedMemorySize, fp::LDS_BYTES) != hipSuccess) { fprintf(stderr, "kernel_launch: hipFuncSetAttribute failed\n"); grid = -1; return; }
        int per_cu = 0; (void)hipOccupancyMaxActiveBlocksPerMultiprocessor(&per_cu, (const void*)fp::fwd, fp::NTHR, fp::LDS_BYTES); (void)hipGetLastError();
        if (per_cu < 1) fprintf(stderr, "kernel_launch: occupancy query says %d\n", per_cu);
        grid = cus;
    }
    if (grid < 0) return;
    fp::Args a{};
    for (int i = 0; i < 33; ++i) a.in[i] = (const float*)d_in[i];
    a.out = (float*)d_out; a.ws = (unsigned char*)d_ws; a.ph_lo = 0; a.ph_hi = fp::NPH;
    auto run = [&](int lo, int hi) {
#if PER_PHASE
        for (int k = lo; k < hi; ++k) fp::launch_range(a, k, k + 1, grid, stream, false);
#else
        fp::launch_range(a, lo, hi, grid, stream, DBG_MODE != 0);
#endif
    };
    (void)hipMemsetAsync((char*)d_ws + fp::WS_CTL, 0, fp::CTL_BYTES, stream);
    run(0, fp::NPH);
}
```

```cpp
#define DBG_MODE 0
#define PER_PHASE 0
#include <hip/hip_runtime.h>
#include <cstdio>
#include <cstdint>
#define LAS __attribute__((address_space(3)))
#define GAS __attribute__((address_space(1)))
typedef unsigned short bf16_t;
typedef short bf16x8 __attribute__((ext_vector_type(8)));
typedef short s16x4 __attribute__((ext_vector_type(4)));
typedef float f32x4 __attribute__((ext_vector_type(4)));
typedef float f32x16 __attribute__((ext_vector_type(16)));
typedef unsigned u32x4 __attribute__((ext_vector_type(4)));
typedef unsigned u32x2 __attribute__((ext_vector_type(2)));
typedef float f32x2 __attribute__((ext_vector_type(2)));

__device__ __forceinline__ unsigned f2bf(float f) { unsigned u = __builtin_bit_cast(unsigned, f); return (u + 0x7fffu + ((u >> 16) & 1u)) >> 16; }
__device__ __forceinline__ unsigned pk2(float lo, float hi) { return f2bf(lo) | (f2bf(hi) << 16); }
__device__ __forceinline__ unsigned cvt_pk_bf16(float lo, float hi) { unsigned r; asm volatile("v_cvt_pk_bf16_f32 %0, %1, %2" : "=v"(r) : "v"(lo), "v"(hi)); return r; }
__device__ __forceinline__ float bf_lo(unsigned w) { return __builtin_bit_cast(float, w << 16); }
__device__ __forceinline__ float bf_hi(unsigned w) { return __builtin_bit_cast(float, w & 0xffff0000u); }
__device__ __forceinline__ float wave_sum(float v) {
#pragma unroll
    for (int o = 1; o < 64; o <<= 1) v += __shfl_xor(v, o);
    return v;
}
__device__ __forceinline__ float fast_sigmoid(float x) { return __builtin_amdgcn_rcpf(1.f + __builtin_amdgcn_exp2f(-1.4426950408889634f * x)); }

namespace pg8 {
constexpr int BM = 256, BK = 64, HALF = 128, HTB = HALF * BK * 2  , STAGE_BYTES = 8 * HTB, NXCD = 8, WGM = 8;
__host__ __device__ __forceinline__ int lds_byte(int r, int c) { const int st = (r >> 4) * 2 + (c >> 5), rr = r & 15, cc = c & 31, ob = rr * 64 + cc * 2; return st * 1024 + (ob ^ (((ob >> 9) & 1) << 5)); }
__host__ __device__ __forceinline__ void stage_rc(int b, int& R, int& C) { const int st = b / 1024, sb = b % 1024, swz = sb ^ (((sb >> 9) & 1) << 5); R = (st >> 1) * 16 + swz / 64; C = (st & 1) * 32 + (swz % 64) / 2; }
__host__ __device__ __forceinline__ int perm32(int rho) { const int n = rho >> 4, i = rho & 15; return 8 * (i >> 2) + 4 * n + (i & 3); }

struct Unit { int pm, pn, ks; };
struct Order {
    int nM, nN, nwg, G, c, rep;
    __device__ __forceinline__ void init(int nM_, int nN_, int G_, int c_, int rep_ = 1) { nM = nM_; nN = nN_; nwg = nM * nN; G = G_; c = c_; rep = rep_; }
    __device__ __forceinline__ bool next(int i, Unit& u) const {
        long L = (long)i * G + c; if (L >= (long)nwg * rep) return false; L %= nwg; map((int)L, u); return true; }
    __device__ __forceinline__ void map(int L, Unit& u) const {
        int wgid = L; u.ks = -1; { const int q = nwg / NXCD, r = nwg % NXCD, xcd = wgid % NXCD, off = wgid / NXCD; wgid = (xcd < r ? xcd * (q + 1) : r * (q + 1) + (xcd - r) * q) + off; }
        const int nig = WGM * nN, gid = wgid / nig, fm = gid * WGM, gsz = (nM - fm) < WGM ? (nM - fm) : WGM;
        u.pm = fm + ((wgid % nig) % gsz); u.pn = (wgid % nig) / gsz;
    }
};

template <class Epi, class Sched, bool ALIGN_EPI = true>
__device__ __forceinline__ void gemm_phase(LAS unsigned char* lds, const int K, const int lda, const int ldb, const Sched& S, const Epi& E) {
    const int tid = threadIdx.x, wid = __builtin_amdgcn_readfirstlane(tid >> 6), lane = tid & 63, wr = wid >> 2, wc = wid & 3, fr = lane & 15, fq = lane >> 4;
    unsigned voffA[2], voffB[2];
#pragma unroll
    for (int i = 0; i < 2; ++i) { int R, C; stage_rc(tid * 16 + i * 8192, R, C); const int Rb = (R & ~31) + perm32(R & 31);
        voffA[i] = (unsigned)(R * lda + C) * 2u; voffB[i] = (unsigned)(Rb * ldb + C) * 2u; }
    const size_t kstep = (size_t)(BK * 2);
    const size_t hstepA = (size_t)HALF * lda * 2, hstepB = (size_t)HALF * ldb * 2;
    const unsigned ldsw = (unsigned)wid * 1024u;
    const int aoff = lds_byte(wr * 64 + fr, fq * 8), boff = lds_byte(wc * 32 + fr, fq * 8);
#define PG8_SA(b, h) (((b) * 2 + (h)) * HTB)
#define PG8_SB(b, h) ((4 + (b) * 2 + (h)) * HTB)
#define PG8_STAGE(bufoff, gbase, voff) do { _Pragma("unroll") for (int _i = 0; _i < 2; ++_i) \
        __builtin_amdgcn_global_load_lds((const unsigned*)((const char*)(gbase) + (voff)[_i]), (LAS unsigned*)(lds + (bufoff) + ldsw + _i * 8192), 16, 0, 0); } while (0)
#define PG8_LDA(dst, b, h) do { _Pragma("unroll") for (int m = 0; m < 4; ++m) _Pragma("unroll") for (int k = 0; k < 2; ++k) dst[m][k] = *(const LAS bf16x8*)(lds + PG8_SA(b, h) + aoff + m * 2048 + k * 1024); } while (0)
#define PG8_LDB(dst, b, h) do { _Pragma("unroll") for (int n = 0; n < 2; ++n) _Pragma("unroll") for (int k = 0; k < 2; ++k) dst[n][k] = *(const LAS bf16x8*)(lds + PG8_SB(b, h) + boff + n * 2048 + k * 1024); } while (0)
#define PG8_MMA(ai, bj, At, Bt) do { __builtin_amdgcn_s_setprio(1); _Pragma("unroll") for (int m = 0; m < 4; ++m) _Pragma("unroll") for (int n = 0; n < 2; ++n) _Pragma("unroll") for (int k = 0; k < 2; ++k) \
        acc[ai][bj][m][n] = __builtin_amdgcn_mfma_f32_16x16x32_bf16(Bt[n][k], At[m][k], acc[ai][bj][m][n], 0, 0, 0); __builtin_amdgcn_s_setprio(0); } while (0)
#define PG8_WAIT_V(n) asm volatile("s_waitcnt vmcnt(" #n ")" ::: "memory")
#define PG8_WAIT_L(n) asm volatile("s_waitcnt lgkmcnt(" #n ")" ::: "memory")
#define PG8_BAR __builtin_amdgcn_s_barrier()
#define PG8_SCHED __builtin_amdgcn_sched_barrier(0)
    Unit cur, nxt; int ui = 0;
    if (!S.next(0, cur)) return;
    f32x4 acc[2][2][4][2];
#pragma unroll
    for (int a = 0; a < 2; ++a)
#pragma unroll
        for (int b = 0; b < 2; ++b)
#pragma unroll
            for (int m = 0; m < 4; ++m)
#pragma unroll
                for (int n = 0; n < 2; ++n) acc[a][b][m][n] = (f32x4){0.f, 0.f, 0.f, 0.f};
    bf16x8 At[4][2], B0[2][2], B1[2][2];
    const char* cA = S.aptr(cur); const char* cB = S.bptr(cur); int nt = S.ktiles(cur); (void)K;
    PG8_STAGE(PG8_SB(0, 0), cB, voffB); PG8_STAGE(PG8_SB(0, 1), cB + hstepB, voffB); PG8_STAGE(PG8_SA(0, 0), cA, voffA); PG8_STAGE(PG8_SA(0, 1), cA + hstepA, voffA);
    if (wr == 1) PG8_BAR;
    PG8_WAIT_V(2); PG8_BAR;
    PG8_STAGE(PG8_SB(1, 0), cB + kstep, voffB); PG8_STAGE(PG8_SA(1, 0), cA + kstep, voffA); PG8_STAGE(PG8_SB(1, 1), cB + hstepB + kstep, voffB);
    PG8_WAIT_V(6); PG8_BAR;
    for (;;) {
        const bool has_next = S.next(ui + 1, nxt);
        const char* nA = has_next ? S.aptr(nxt) : cA; const char* nB = has_next ? S.bptr(nxt) : cB;
#pragma unroll 1
        for (int t = 0; t < nt; t += 2) {
            const bool last = (t == nt - 2);
            const char* a1 = cA + (size_t)(t + 1) * kstep;
            const char* a2 = last ? nA : cA + (size_t)(t + 2) * kstep; const char* b2 = last ? nB : cB + (size_t)(t + 2) * kstep;
            const char* a3 = a2 + kstep; const char* b3 = b2 + kstep;
            PG8_LDB(B0, 0, 0); PG8_LDB(B1, 0, 1); PG8_SCHED; PG8_LDA(At, 0, 0); PG8_STAGE(PG8_SA(1, 1), a1 + hstepA, voffA);
            PG8_WAIT_V(8); PG8_WAIT_L(0); PG8_BAR; PG8_MMA(0, 0, At, B0); PG8_MMA(0, 1, At, B1); PG8_BAR; PG8_SCHED;
            PG8_LDA(At, 0, 1); PG8_STAGE(PG8_SB(0, 0), b2, voffB); PG8_STAGE(PG8_SB(0, 1), b2 + hstepB, voffB); PG8_STAGE(PG8_SA(0, 0), a2, voffA);
            PG8_WAIT_V(8); PG8_WAIT_L(0); PG8_BAR; PG8_MMA(1, 0, At, B0); PG8_MMA(1, 1, At, B1); PG8_BAR; PG8_SCHED;
            PG8_LDB(B0, 1, 0); PG8_LDB(B1, 1, 1); PG8_SCHED; PG8_LDA(At, 1, 0); PG8_STAGE(PG8_SA(0, 1), a2 + hstepA, voffA);
            PG8_WAIT_V(8); PG8_WAIT_L(0); PG8_BAR; PG8_MMA(0, 0, At, B0); PG8_MMA(0, 1, At, B1); PG8_BAR; PG8_SCHED;
            PG8_LDA(At, 1, 1); PG8_STAGE(PG8_SB(1, 0), b3, voffB); PG8_STAGE(PG8_SB(1, 1), b3 + hstepB, voffB); PG8_STAGE(PG8_SA(1, 0), a3, voffA);
            PG8_WAIT_V(8); PG8_WAIT_L(0); PG8_BAR; PG8_MMA(1, 0, At, B0); PG8_MMA(1, 1, At, B1); PG8_BAR; PG8_SCHED;
        }
        if constexpr (ALIGN_EPI) { if (wr == 0) PG8_BAR; }
        E(acc, cur, wr, wc, fr, fq);
        if (!has_next) break;
#pragma unroll
        for (int a = 0; a < 2; ++a)
#pragma unroll
            for (int b = 0; b < 2; ++b)
#pragma unroll
                for (int m = 0; m < 4; ++m)
#pragma unroll
                    for (int n = 0; n < 2; ++n) acc[a][b][m][n] = (f32x4){0.f, 0.f, 0.f, 0.f};
        cur = nxt; cA = nA; cB = nB; ++ui; nt = S.ktiles(cur);
        if constexpr (ALIGN_EPI) { if (wr == 1) PG8_BAR; }
    }
    PG8_WAIT_V(0);
    if constexpr (!ALIGN_EPI) { if (wr == 0) PG8_BAR; }
    PG8_BAR;
#undef PG8_SA
#undef PG8_SB
#undef PG8_STAGE
#undef PG8_LDA
#undef PG8_LDB
#undef PG8_MMA
#undef PG8_WAIT_V
#undef PG8_WAIT_L
#undef PG8_BAR
#undef PG8_SCHED
}
}

#define XB_TMO      128
#define XB_XCNT(j)  (256  + 64 * (j))
#define XB_XSUB(j)  (1280 + 64 * (j))
#define XB_XGEN(j)  (2304 + 64 * (j))
#define XB_TOP      3328
#define XB_TOPGEN   3392
#define XCD_BAR_WORDS 3456
#define XB_SPIN_CAP (1u << 18)
__device__ __forceinline__ unsigned xb_ld(unsigned* p)              { return __hip_atomic_load(p, __ATOMIC_RELAXED, __HIP_MEMORY_SCOPE_AGENT); }
__device__ __forceinline__ unsigned xb_add(unsigned* p, unsigned v) { return __hip_atomic_fetch_add(p, v, __ATOMIC_RELAXED, __HIP_MEMORY_SCOPE_AGENT); }
__device__ __forceinline__ unsigned xb_xcc_id() { return (unsigned)__builtin_amdgcn_s_getreg((3 << 11) | 20) & 0xFu; }
#define XB_SPIN(cond, bar) do { unsigned _sp = 0; while (cond) { __builtin_amdgcn_s_sleep(1); \
    if ((++_sp & 255u) == 0u) { if (xb_ld(&(bar)[XB_TMO])) break; if (_sp > XB_SPIN_CAP) { atomicAdd(&(bar)[XB_TMO], 1u); break; } } } } while (0)
struct XcdBarrier { unsigned* bar; unsigned x; volatile LAS unsigned* st; };
__device__ __forceinline__ XcdBarrier xcd_barrier_post(unsigned* bar, volatile LAS unsigned* st) {
    XcdBarrier b; b.bar = bar; b.x = xb_xcc_id(); b.st = st;
    if (threadIdx.x == 0) (void)xb_add(&bar[XB_XCNT(b.x)], 1u);
    return b;
}
__device__ __forceinline__ void xcd_barrier_complete(unsigned* bar, unsigned x, unsigned& nloc, unsigned& nx) {
    const unsigned G = gridDim.x * gridDim.y * gridDim.z;
    unsigned sum, cnt, mine, sp = 0u;
    for (;;) {
        sum = 0u; cnt = 0u; mine = 0u;
#pragma unroll
        for (unsigned j = 0; j < 16; ++j) { const unsigned c = xb_ld(&bar[XB_XCNT(j)]); sum += c; cnt += (c > 0u) ? 1u : 0u; mine = (j == x) ? c : mine; }
        if (sum == G) break;
        __builtin_amdgcn_s_sleep(1);
        if ((++sp & 255u) == 0u) { if (xb_ld(&bar[XB_TMO])) break; if (sp > XB_SPIN_CAP) { atomicAdd(&bar[XB_TMO], 1u); break; } }
    }
    nloc = mine > 0u ? mine : 1u; nx = cnt > 0u ? cnt : 1u;
}
__device__ __forceinline__ void xcd_barrier(const XcdBarrier& b) {
    asm volatile("s_waitcnt vmcnt(0)" ::: "memory");
    __syncthreads();
    if (threadIdx.x == 0) {
        unsigned* bar = b.bar;
        __builtin_amdgcn_s_waitcnt(0);
        unsigned nloc = b.st[0], nx = b.st[1];
        if (nloc == 0u) { xcd_barrier_complete(bar, b.x, nloc, nx); b.st[0] = nloc; b.st[1] = nx; }
        const unsigned old = xb_add(&bar[XB_XSUB(b.x)], 1u);
        const unsigned gen = old / nloc;
        if (old + 1u == (gen + 1u) * nloc) {
            __builtin_amdgcn_fence(__ATOMIC_RELEASE, "agent");
            asm volatile("s_waitcnt vmcnt(0)" ::: "memory");
            const unsigned og = xb_add(&bar[XB_TOP], 1u);
            const unsigned tg = og / nx;
            if (og + 1u == (tg + 1u) * nx) xb_add(&bar[XB_TOPGEN], 1u);
            else XB_SPIN(xb_ld(&bar[XB_TOPGEN]) == tg, bar);
            __builtin_amdgcn_fence(__ATOMIC_ACQUIRE, "agent");
            xb_add(&bar[XB_XGEN(b.x)], 1u);
            asm volatile("s_waitcnt vmcnt(0)" ::: "memory");
        } else {
            XB_SPIN(xb_ld(&bar[XB_XGEN(b.x)]) == gen, bar);
            __builtin_amdgcn_fence(__ATOMIC_ACQUIRE, "agent");
            asm volatile("s_waitcnt vmcnt(0)" ::: "memory");
        }
    }
    __syncthreads();
}
namespace fp {
constexpr int D = 1024, NB = 4, SEQ = 4096, CTX = 256, ML = NB * SEQ, MC = NB * CTX, MT = ML + MC;
constexpr int NIN = 2304;
constexpr int DFF = 2816, DFE = 3584, NE = 8;
#ifndef DFFP
#define DFFP 2816
#endif
constexpr int LDF = DFFP;
constexpr int NWAVES = 8, NTHR = 512;
constexpr float LOG2E = 1.4426950408889634f;
constexpr float C2_MLA = 0.10206207261596577f * LOG2E;
constexpr float C2_NA = 0.125f * LOG2E;
constexpr float EPS = 1e-6f;
constexpr int TCH = 32, NCH = SEQ / TCH  , NCHC = CTX / TCH  , SK = TCH * 16  , SKA = SK + 256  ;

constexpr size_t MiB = 1u << 20;
constexpr size_t WS_CTL = 0, CTL_BYTES = 1 * MiB;
constexpr size_t WS_SSQ = 10 * MiB;
constexpr size_t CTL_CNT = 256 * 1024;
constexpr size_t CTL_DONE = 280 * 1024;
constexpr size_t CTL_ADALN = 290 * 1024;
constexpr size_t CTL_TS = 310 * 1024;
constexpr size_t CTL_Q0 = 300 * 1024;
constexpr size_t WS_MODP = 1 * MiB;
constexpr size_t WS_TOK = WS_MODP + 256 * 1024;
constexpr size_t WS_XC = 2 * MiB;
constexpr size_t WS_KKER = 6 * MiB;
constexpr size_t WS_WMOE_GU = 12 * MiB;
constexpr size_t WS_WMOE_D = WS_WMOE_GU + 112 * MiB;
constexpr size_t WS_C = 180 * MiB;
constexpr size_t WS_WIN0 = WS_C;
constexpr size_t WS_WQB = WS_WIN0 + (size_t)NIN * D * 2;
constexpr size_t WS_WKVB = WS_WQB + 768 * 384 * 2;
constexpr size_t WS_WOUT = WS_WKVB + 1024 * 256 * 2;
constexpr size_t WS_WFGU = WS_WOUT + 1024 * 1024 * 2;
constexpr size_t WS_WFD = WS_WFGU + (size_t)5632 * 1024 * 2;
constexpr size_t WS_WS5 = WS_WFD + (size_t)1024 * LDF * 2;
constexpr size_t WS_WGLU = WS_WS5 + 1024 * 1024 * 2;
constexpr size_t WS_BHAT = WS_WGLU + 2048 * 1024 * 2;
constexpr size_t WS_LT = WS_BHAT + (size_t)64 * 256 * SK * 2;
constexpr size_t WS_WEND = WS_LT + (size_t)64 * 512 * SKA * 2;
static_assert(WS_WEND <= 275 * MiB, "non-moe weights region");
constexpr size_t WS_ACT = 275 * MiB;
constexpr size_t WS_HB = 479 * MiB;
constexpr size_t WS_END = WS_HB + (size_t)MT * D * 2;
static_assert(WS_END <= 513 * MiB, "ws end");
constexpr size_t WS_P = WS_ACT;
constexpr size_t WS_Q = WS_P + (size_t)MT * NIN * 2;
constexpr size_t WS_KF = WS_Q + (size_t)MT * 768 * 2;
constexpr size_t WS_V = WS_KF + (size_t)MT * 768 * 2;
constexpr size_t WS_AO = WS_V + (size_t)MT * 512 * 2;
static_assert(WS_AO + (size_t)MT * D * 2 <= WS_HB, "L0 mixer activations");
constexpr size_t WS_HF = WS_ACT;
static_assert(WS_HF + (size_t)MT * LDF * 2 <= WS_AO, "HF must not overlay AO (w_out reads AO before HF is written? no: separate phases, but keep clear)");
constexpr size_t WS_ACAT = WS_ACT;
constexpr size_t WS_ACATC = WS_ACAT + (size_t)64 * 512 * SKA * 2;
constexpr size_t WS_SLOC = WS_ACATC + (size_t)(64 * 32 + 256) * SKA * 2;
constexpr size_t WS_GB = WS_SLOC + (size_t)64 * 544 * 256 * 4;
static_assert(WS_GB + (size_t)ML * D * 2 <= WS_HB, "L1 mixer activations");
constexpr size_t WS_Y1 = WS_ACT;
constexpr size_t WS_Y2 = WS_AO;
constexpr size_t WS_Y3 = 400 * MiB;
static_assert(WS_GB + (size_t)ML * D * 2 <= WS_Y3 && WS_Y3 + (size_t)ML * D * 2 <= WS_HB, "Y3 placement");
constexpr size_t WS_PART5 = 320 * MiB;
constexpr size_t WS_PART8 = 372 * MiB;
static_assert(WS_PART8 + (size_t)11 * MC * D * 4 <= WS_Y2 && WS_HF + (size_t)MT * LDF * 2 <= WS_PART8, "PART8 placement");
constexpr size_t WS_PART18 = WS_WMOE_GU;
constexpr int MOE_ROWS = 2 * ML + NE * 256;
constexpr size_t WS_XG = WS_C;
constexpr size_t WS_HM = WS_XG + (size_t)MOE_ROWS * D * 2;
static_assert(WS_HM + (size_t)MOE_ROWS * DFE * 2 <= 513 * MiB, "moe hidden");

constexpr int RING_BYTES = 131072;
constexpr int LDS_ROPE = RING_BYTES;
constexpr int LDS_MISC = LDS_ROPE + 4096;
constexpr int LDS_MOE = LDS_MISC + 256;
constexpr int LDS_BIAS = LDS_MOE + 1024;
constexpr int LDS_BYTES = 147456;
static_assert(LDS_BIAS + 2048 <= LDS_BYTES, "lds map");

struct Args {
    const float* in[33];
    float* out; unsigned char* ws;
    int ph_lo, ph_hi;
};
enum { I_x = 0, I_c, I_ctx, I_cctx, I_modw, I_modb, I_n1g, I_n2g, I_win, I_qng, I_wqb, I_kvng, I_wkvb, I_rpb, I_wout, I_fg, I_fu, I_fd, I_s5in, I_are, I_aim, I_lstep, I_bre, I_bim, I_cre, I_cim, I_odd, I_wglu,
       I_router, I_mg, I_mu, I_md, I_fing };

struct Frame {
    LAS unsigned char* lds;
    int tid, lane, wave, vcu, G, tailconv, wait_adaln;
    const Args* a;
    unsigned char* ws;
};
__device__ __forceinline__ int cond_of_tile(int pm) { return pm < 64 ? (pm >> 4) : NB; }
__device__ __forceinline__ int cond_of_row(int row) { return row < ML ? row / SEQ : NB; }

struct ConvSrc { const float* src; int ld; int col0; int perm; float scale; const float* gain; };
__device__ __forceinline__ int rope_src_dim(int c) { return (c & 16) + ((c & 1) ? 8 : 0) + ((c & 15) >> 1); }
struct ConvItem { ConvSrc cs; bf16_t* dst; int ldd, n0, k0; };
__device__ __forceinline__ void conv_load(const ConvItem& ci, f32x4 (&v)[8], int lane) {
    if (ci.cs.col0 >= 0) {
        const int c4 = 4 * (lane & 7), r8 = lane >> 3;
        const float* sp = ci.cs.src + (size_t)(ci.k0 + r8) * ci.cs.ld + ci.cs.col0 + c4;
#pragma unroll
        for (int i = 0; i < 8; ++i) v[i] = *(const f32x4*)(sp + (size_t)(8 * i) * ci.cs.ld);
    }
}
__device__ __forceinline__ void conv_finish(const ConvItem& ci, const f32x4 (&v)[8], LAS float* scr, int lane) {
    const ConvSrc& cs = ci.cs;
    if (cs.col0 >= 0) {
        const int c4 = 4 * (lane & 7), r8 = lane >> 3;
#pragma unroll
        for (int i = 0; i < 8; ++i) { const int kk = r8 + 8 * i; float g = cs.scale; if (cs.gain) g *= cs.gain[ci.k0 + kk];
            scr[kk * 33 + c4] = v[i].x * g; scr[kk * 33 + c4 + 1] = v[i].y * g; scr[kk * 33 + c4 + 2] = v[i].z * g; scr[kk * 33 + c4 + 3] = v[i].w * g; }
    }
    asm volatile("s_waitcnt lgkmcnt(0)" ::: "memory");
    const int c = lane & 7;
#pragma unroll
    for (int j = 0; j < 4; ++j) { const int n = (lane >> 3) + 8 * j; const int ns = cs.perm ? rope_src_dim(n) : n; const LAS float* s = scr + (8 * c) * 33 + ns;
        u32x4 o;
        if (cs.col0 >= 0) { o.x = cvt_pk_bf16(s[0 * 33], s[1 * 33]); o.y = cvt_pk_bf16(s[2 * 33], s[3 * 33]); o.z = cvt_pk_bf16(s[4 * 33], s[5 * 33]); o.w = cvt_pk_bf16(s[6 * 33], s[7 * 33]); }
        else o = (u32x4){0u, 0u, 0u, 0u};
        *(u32x4*)(ci.dst + (size_t)(ci.n0 + n) * ci.ldd + ci.k0 + 8 * c) = o; }
    asm volatile("s_waitcnt lgkmcnt(0)" ::: "memory");
}
__device__ __forceinline__ ConvSrc gu_src(const float* ga, const float* gb, int ld, int n0) { const int tile = n0 >> 8, w = n0 & 255; ConvSrc c; c.src = w < 128 ? ga : gb; c.ld = ld; c.col0 = tile * 128 + (w & 127); c.perm = 0; c.scale = 1.f; c.gain = nullptr; return c; }

__device__ __forceinline__ f32x4 s5_disc(const Args& a, int g, int dir, int p) {
    const float dt = expf(a.in[I_lstep][dir * 64 + g]); const float ar = a.in[I_are][(dir * 64 + g) * 64 + p], ai = a.in[I_aim][(dir * 64 + g) * 64 + p];
    const float decay = expf(ar * dt), abr = decay * cosf(ai * dt), abi = decay * sinf(ai * dt), den = ar * ar + ai * ai;
    const float fr = ((abr - 1.f) * ar + abi * ai) / den, fi = (abi * ar - (abr - 1.f) * ai) / den;
    return (f32x4){ar * dt, ai * dt, fr, fi};
}
__device__ __forceinline__ f32x2 s5_adt(const Args& a, int g, int dir, int p) { const float dt = expf(a.in[I_lstep][dir * 64 + g]); return (f32x2){a.in[I_are][(dir * 64 + g) * 64 + p] * dt, a.in[I_aim][(dir * 64 + g) * 64 + p] * dt}; }
__device__ __forceinline__ f32x2 cpow(float ardt, float aidt, float n) { const float m = __builtin_amdgcn_exp2f(ardt * n * LOG2E), rev = aidt * n * 0.15915494309189535f; return (f32x2){m * __builtin_amdgcn_cosf(rev), m * __builtin_amdgcn_sinf(rev)}; }

constexpr int CI_WIN0 = 0, CN_WIN0 = (D / 64) * (NIN / 32);
constexpr int CI_WQB = CI_WIN0 + CN_WIN0, CN_WQB = (384 / 64) * (768 / 32);
constexpr int CI_WKVB = CI_WQB + CN_WQB, CN_WKVB = (256 / 64) * (1024 / 32);
constexpr int CI_WOUT = CI_WKVB + CN_WKVB, CN_WOUT = (D / 64) * (D / 32);
constexpr int CI_WFGU = CI_WOUT + CN_WOUT, CN_WFGU = (D / 64) * (5632 / 32);
constexpr int CI_WFD = CI_WFGU + CN_WFGU, CN_WFD = (DFF / 64) * (D / 32);
constexpr int CI_WS5 = CI_WFD + CN_WFD, CN_WS5 = (D / 64) * (D / 32);
constexpr int CI_WGLU = CI_WS5 + CN_WS5, CN_WGLU = (D / 64) * (2048 / 32);
constexpr int CI_MGU = CI_WGLU + CN_WGLU, CN_MGU1 = (D / 64) * (7168 / 32), CN_MGU = NE * CN_MGU1;
constexpr int CI_MD = CI_MGU + CN_MGU, CN_MD1 = (DFE / 64) * (D / 32), CN_MD = NE * CN_MD1;
#ifndef TC_P0
#define TC_P0 1792
#endif
constexpr int CI_KK = CI_MD + CN_MD, CN_KK = 64 * 2 * TCH;
constexpr int CI_BH = CI_KK + CN_KK, CN_BH = 64 * 2;
constexpr int CI_END = CI_BH + CN_BH;

__device__ __forceinline__ ConvItem conv_decode(const Args& a, unsigned char* ws, int it) {
    ConvItem ci;
        if (it < CI_MGU) {
            ConvSrc cs; cs.perm = 0; cs.scale = 1.f; cs.gain = nullptr; bf16_t* dst; int ldd, n0, k0;
            if (it < CI_WQB) { const int r = it - CI_WIN0, nblk = NIN / 32; k0 = 64 * (r / nblk); n0 = 32 * (r % nblk); dst = (bf16_t*)(ws + WS_WIN0); ldd = D;
                cs.src = a.in[I_win]; cs.ld = 2208; cs.col0 = n0 < 2208 ? n0 : -1; cs.perm = (n0 == 640); cs.scale = (n0 >= 672 && n0 < 1184) ? C2_NA : 1.f; }
            else if (it < CI_WKVB) { const int r = it - CI_WQB, nblk = 768 / 32; k0 = 64 * (r / nblk); n0 = 32 * (r % nblk); dst = (bf16_t*)(ws + WS_WQB); ldd = 384;
                cs.src = a.in[I_wqb]; cs.ld = 768; cs.col0 = n0; cs.perm = ((n0 % 96) == 64); cs.gain = a.in[I_qng]; }
            else if (it < CI_WOUT) { const int r = it - CI_WKVB, nblk = 1024 / 32; k0 = 64 * (r / nblk); n0 = 32 * (r % nblk); dst = (bf16_t*)(ws + WS_WKVB); ldd = 256;
                cs.src = a.in[I_wkvb]; cs.ld = 1024; cs.col0 = n0; cs.gain = a.in[I_kvng]; }
            else if (it < CI_WFGU) { const int r = it - CI_WOUT, nblk = D / 32; k0 = 64 * (r / nblk); n0 = 32 * (r % nblk); dst = (bf16_t*)(ws + WS_WOUT); ldd = D; cs.src = a.in[I_wout]; cs.ld = D; cs.col0 = n0; }
            else if (it < CI_WFD) { const int r = it - CI_WFGU, nblk = 5632 / 32; k0 = 64 * (r / nblk); n0 = 32 * (r % nblk); dst = (bf16_t*)(ws + WS_WFGU); ldd = D; cs = gu_src(a.in[I_fg], a.in[I_fu], DFF, n0); }
            else if (it < CI_WS5) { const int r = it - CI_WFD, nblk = D / 32; k0 = 64 * (r / nblk); n0 = 32 * (r % nblk); dst = (bf16_t*)(ws + WS_WFD); ldd = LDF; cs.src = a.in[I_fd]; cs.ld = D; cs.col0 = n0; }
            else if (it < CI_WGLU) { const int r = it - CI_WS5, nblk = D / 32; k0 = 64 * (r / nblk); n0 = 32 * (r % nblk); dst = (bf16_t*)(ws + WS_WS5); ldd = D; cs.src = a.in[I_s5in]; cs.ld = D; cs.col0 = n0; }
            else { const int r = it - CI_WGLU, nblk = 2048 / 32; k0 = 64 * (r / nblk); n0 = 32 * (r % nblk); dst = (bf16_t*)(ws + WS_WGLU); ldd = D; cs = gu_src(a.in[I_wglu], a.in[I_wglu] + 1024, 2048, n0); }
            ci.cs = cs; ci.dst = dst; ci.ldd = ldd; ci.n0 = n0; ci.k0 = k0;
        } else if (it < CI_MD) {
            const int r0 = it - CI_MGU, e = r0 / CN_MGU1, r = r0 % CN_MGU1, nblk = 7168 / 32; const int k0 = 64 * (r / nblk), n0 = 32 * (r % nblk);
            ConvSrc cs = gu_src(a.in[I_mg] + (size_t)e * D * DFE, a.in[I_mu] + (size_t)e * D * DFE, DFE, n0);
            ci.cs = cs; ci.dst = (bf16_t*)(ws + WS_WMOE_GU) + (size_t)e * 7168 * D; ci.ldd = D; ci.n0 = n0; ci.k0 = k0;
        } else if (it < CI_KK) {
            const int r0 = it - CI_MD, e = r0 / CN_MD1, r = r0 % CN_MD1, nblk = D / 32; const int k0 = 64 * (r / nblk), n0 = 32 * (r % nblk);
            ConvSrc cs; cs.src = a.in[I_md] + (size_t)e * DFE * D; cs.ld = D; cs.col0 = n0; cs.perm = 0; cs.scale = 1.f; cs.gain = nullptr;
            ci.cs = cs; ci.dst = (bf16_t*)(ws + WS_WMOE_D) + (size_t)e * D * DFE; ci.ldd = DFE; ci.n0 = n0; ci.k0 = k0;
        }
    return ci;
}
__device__ __forceinline__ void conv4(const Args& a, unsigned char* ws, const int (&it)[4], const bool (&ok)[4], LAS float* scr, int lane) {
    ConvItem ci[4]; f32x4 v[4][8];
#pragma unroll
    for (int i = 0; i < 4; ++i) if (ok[i]) { ci[i] = conv_decode(a, ws, it[i]); conv_load(ci[i], v[i], lane); }
#pragma unroll
    for (int i = 0; i < 4; ++i) if (ok[i]) conv_finish(ci[i], v[i], scr, lane);
}
__device__ __forceinline__ void p0_prologue(Frame& F, int qsel) {
    const Args& a = *F.a; unsigned char* ws = F.ws;
    {
        LAS float* part = (LAS float*)F.lds;
        LAS float* scnd = part + 8 * 5 * 64;
        float* modp = (float*)(ws + WS_MODP);
        if ((int)blockIdx.x < 2 * 96) {
            for (int i = F.tid; i < 5 * D; i += NTHR) { const int r = i >> 10, k = i & 1023; const float cv = r < 4 ? a.in[I_c][r * D + k] : a.in[I_cctx][k]; scnd[i] = cv * fast_sigmoid(cv); }
            __syncthreads();
        }
        for (int it = blockIdx.x; it < 2 * 96; it += F.G) {
            const int l = it / 96, cb = it % 96, col = cb * 64 + F.lane;
            const float* W = a.in[I_modw] + (size_t)l * D * 6144 + col;
            float acc[5] = {0.f, 0.f, 0.f, 0.f, 0.f};
            const int kb = F.wave * 128;
#pragma unroll 2
            for (int k0 = kb; k0 < kb + 128; k0 += 16) {
                float wv[16];
#pragma unroll
                for (int j = 0; j < 16; ++j) wv[j] = W[(size_t)(k0 + j) * 6144];
#pragma unroll
                for (int j = 0; j < 16; ++j)
#pragma unroll
                    for (int r = 0; r < 5; ++r) acc[r] += scnd[r * D + k0 + j] * wv[j];
            }
#pragma unroll
            for (int r = 0; r < 5; ++r) part[(F.wave * 5 + r) * 64 + F.lane] = acc[r];
            __syncthreads();
            if (F.wave < 5) { const int r = F.wave; float sum = 0.f;
#pragma unroll
                for (int w = 0; w < 8; ++w) sum += part[(w * 5 + r) * 64 + F.lane];
                modp[(l * 5 + r) * 6144 + col] = sum + a.in[I_modb][l * 6144 + col]; }
            asm volatile("s_waitcnt vmcnt(0)" ::: "memory");
            __syncthreads();
            if (F.tid == 0) { __builtin_amdgcn_fence(__ATOMIC_RELEASE, "agent"); asm volatile("s_waitcnt vmcnt(0)" ::: "memory");
                (void)__hip_atomic_fetch_add((unsigned*)(ws + WS_CTL + CTL_ADALN), 1u, __ATOMIC_RELAXED, __HIP_MEMORY_SCOPE_AGENT); }
        }
    }
    LAS float* scr = (LAS float*)(F.lds + F.wave * 16384);
    const int gw = F.vcu * NWAVES + F.wave, NGW = F.G * NWAVES, lane = F.lane;
    unsigned* qctr = (unsigned*)(ws + WS_CTL + CTL_Q0) + 64 * qsel;
    const int conv_end = F.tailconv ? CI_MGU + 8 * TC_P0 : CI_KK;
    constexpr int QB_KK = CN_BH / 8, QB_CONV = QB_KK + CN_KK / 32; const int QB_END = QB_CONV + (conv_end + 127) / 128;
    constexpr int QC_KK = CN_BH, QC_CONV = QC_KK + CN_KK / 4;
    volatile LAS int* qslot = (volatile LAS int*)(F.lds + LDS_MISC + 64);
    for (;;) {
      __syncthreads();
      if (F.tid == 0) qslot[0] = (int)__hip_atomic_fetch_add(qctr, 1u, __ATOMIC_RELAXED, __HIP_MEMORY_SCOPE_AGENT);
      __syncthreads();
      const int cbk = __builtin_amdgcn_readfirstlane(qslot[0]); if (cbk >= QB_END) break;
      const int c = cbk < QB_KK ? cbk * 8 + F.wave : (cbk < QB_CONV ? QC_KK + (cbk - QB_KK) * 8 + F.wave : QC_CONV + (cbk - QB_CONV));
      if (c < QC_KK) { const int it = c;
            const int r = it, g = r >> 1, dir = r & 1, p = lane;
            const f32x4 dsc = s5_disc(a, g, dir, p);
            float br[16], bi[16];
            const float* bre = a.in[I_bre] + ((size_t)(dir * 64 + g) * 64 + p) * 16; const float* bim = a.in[I_bim] + ((size_t)(dir * 64 + g) * 64 + p) * 16;
#pragma unroll
            for (int i = 0; i < 16; ++i) { const float x = bre[i], y = bim[i]; br[i] = dsc.z * x - dsc.w * y; bi[i] = dsc.z * y + dsc.w * x; }
            bf16_t* rowr = (bf16_t*)(ws + WS_BHAT) + ((size_t)g * 256 + dir * 128 + p) * SK; bf16_t* rowi = rowr + (size_t)64 * SK;
            const f32x2 a1 = cpow(dsc.x, dsc.y, 1.f); f32x2 ap = (f32x2){1.f, 0.f};
            for (int e = 0; e < TCH; ++e) {
                const int s = dir ? e : TCH - 1 - e;
                u32x4 o0, o1, q0, q1; float vr[16], vi[16];
#pragma unroll
                for (int i = 0; i < 16; ++i) { vr[i] = ap.x * br[i] - ap.y * bi[i]; vi[i] = ap.x * bi[i] + ap.y * br[i]; }
                o0 = (u32x4){cvt_pk_bf16(vr[0], vr[1]), cvt_pk_bf16(vr[2], vr[3]), cvt_pk_bf16(vr[4], vr[5]), cvt_pk_bf16(vr[6], vr[7])}; o1 = (u32x4){cvt_pk_bf16(vr[8], vr[9]), cvt_pk_bf16(vr[10], vr[11]), cvt_pk_bf16(vr[12], vr[13]), cvt_pk_bf16(vr[14], vr[15])};
                q0 = (u32x4){cvt_pk_bf16(vi[0], vi[1]), cvt_pk_bf16(vi[2], vi[3]), cvt_pk_bf16(vi[4], vi[5]), cvt_pk_bf16(vi[6], vi[7])}; q1 = (u32x4){cvt_pk_bf16(vi[8], vi[9]), cvt_pk_bf16(vi[10], vi[11]), cvt_pk_bf16(vi[12], vi[13]), cvt_pk_bf16(vi[14], vi[15])};
                *(u32x4*)(rowr + s * 16) = o0; *(u32x4*)(rowr + s * 16 + 8) = o1; *(u32x4*)(rowi + s * 16) = q0; *(u32x4*)(rowi + s * 16 + 8) = q1;
                ap = (f32x2){ap.x * a1.x - ap.y * a1.y, ap.x * a1.y + ap.y * a1.x};
            }
      } else if (c < QC_CONV) {
        const int ck = c - QC_KK, g = ck >> 4, dir = (ck >> 3) & 1, tau0 = (ck & 7) * 4;
        { const f32x4* s0 = (const f32x4*)(a.in[I_cre] + (size_t)(dir * 64 + g) * 1024); const f32x4* s1 = (const f32x4*)(a.in[I_cim] + (size_t)(dir * 64 + g) * 1024);
          const f32x4* s2 = (const f32x4*)(a.in[I_bre] + (size_t)(dir * 64 + g) * 1024); const f32x4* s3 = (const f32x4*)(a.in[I_bim] + (size_t)(dir * 64 + g) * 1024);
          f32x4 t0[4], t1[4], t2[4], t3[4];
#pragma unroll
          for (int j = 0; j < 4; ++j) { t0[j] = s0[lane + 64 * j]; t1[j] = s1[lane + 64 * j]; t2[j] = s2[lane + 64 * j]; t3[j] = s3[lane + 64 * j]; }
#pragma unroll
          for (int j = 0; j < 4; ++j) { ((LAS f32x4*)scr)[lane + 64 * j] = t0[j]; ((LAS f32x4*)scr)[256 + lane + 64 * j] = t1[j]; ((LAS f32x4*)scr)[512 + lane + 64 * j] = t2[j]; ((LAS f32x4*)scr)[768 + lane + 64 * j] = t3[j]; } }
        asm volatile("s_waitcnt lgkmcnt(0)" ::: "memory");
        const f32x4 dsc = s5_disc(a, g, dir, lane);
        const int o = lane >> 2, i0 = 4 * (lane & 3);
        const LAS float* Cr = scr + o * 64; const LAS float* Ci = scr + 1024 + o * 64; const LAS float* Br = scr + 2048 + i0; const LAS float* Bi = scr + 3072 + i0;
        for (int tt = 0; tt < 4; ++tt) {
            const int tau = tau0 + tt;
            const f32x2 ap = cpow(dsc.x, dsc.y, (float)tau);
            const float gr_ = ap.x * dsc.z - ap.y * dsc.w, gi_ = ap.x * dsc.w + ap.y * dsc.z;
            f32x4 acc = (f32x4){0.f, 0.f, 0.f, 0.f};
#pragma unroll 8
            for (int p = 0; p < 64; ++p) {
                const float xr = __builtin_bit_cast(float, __builtin_amdgcn_readlane(__builtin_bit_cast(int, gr_), p)), xi = __builtin_bit_cast(float, __builtin_amdgcn_readlane(__builtin_bit_cast(int, gi_), p));
                const float cr = Cr[p], ci = Ci[p];
                const float hr = cr * xr - ci * xi, hi = cr * xi + ci * xr;
                const f32x4 br = *(const LAS f32x4*)(Br + p * 16), bi = *(const LAS f32x4*)(Bi + p * 16);
                acc += hr * br - hi * bi;
            }
            *(f32x4*)((float*)(ws + WS_KKER) + ((size_t)((g * 2 + dir) * 16 + o) * TCH + tau) * 16 + i0) = acc;
        }
        asm volatile("s_waitcnt lgkmcnt(0)" ::: "memory");
      } else {
        const int itb = (c - QC_CONV) * 128 + F.wave; const int ite = ((c - QC_CONV) * 128 + 128 < conv_end) ? (c - QC_CONV) * 128 + 128 : conv_end;
        for (int it0 = itb; it0 < ite; it0 += 32) {
            int it[4]; bool ok[4];
#pragma unroll
            for (int i = 0; i < 4; ++i) { it[i] = it0 + 8 * i; ok[i] = it[i] < ite; }
            conv4(a, ws, it, ok, scr, lane);
        }
      }
    }
    (void)gw; (void)NGW;
}

constexpr int TC_CHUNKS = (CI_KK - CI_MGU) / 8;
__device__ __forceinline__ void tail_convert(Frame& F, int cb, int ce, int j, int n_idle) {
    const Args& a = *F.a; unsigned char* ws = F.ws; LAS float* scr = (LAS float*)(F.lds + F.wave * 16384); const int lane = F.lane;
    if (ce > TC_CHUNKS) ce = TC_CHUNKS;
    for (int ch = cb + j; ch < ce; ch += 4 * n_idle) {
        int it[4]; bool ok[4];
#pragma unroll
        for (int i = 0; i < 4; ++i) { const int c = ch + i * n_idle; ok[i] = c < ce; it[i] = CI_MGU + c * 8 + F.wave; }
        conv4(a, ws, it, ok, scr, lane);
    }
}
template <int NR, bool RES, bool TO_LDS = false>
__device__ __forceinline__ void modulate_rows(const float* const (&xrow)[NR], const bf16_t* const (&yrow)[NR], const float* const (&gate)[NR], float* const (&xout)[NR],
                                              const float* g, const float* const (&mpsh)[NR], const float* const (&mpsc)[NR], bf16_t* const (&orow)[NR], int lane, f32x4 (&v)[NR][4], LAS u32x2* const* lrow = nullptr) {
    u32x2 yv[NR][4];
#pragma unroll
    for (int r = 0; r < NR; ++r) if (xrow[r]) {
#pragma unroll
        for (int j = 0; j < 4; ++j) { v[r][j] = ((const f32x4*)xrow[r])[lane + 64 * j]; if (RES) yv[r][j] = ((const u32x2*)yrow[r])[lane + 64 * j]; } }
    f32x4 gg[4];
#pragma unroll
    for (int j = 0; j < 4; ++j) gg[j] = ((const f32x4*)g)[lane + 64 * j];
#pragma unroll
    for (int r = 0; r < NR; ++r) if (xrow[r]) {
        float s = 0.f;
#pragma unroll
        for (int j = 0; j < 4; ++j) {
            if (RES) { const f32x4 gt = ((const f32x4*)gate[r])[lane + 64 * j]; v[r][j] = v[r][j] + gt * (f32x4){bf_lo(yv[r][j].x), bf_hi(yv[r][j].x), bf_lo(yv[r][j].y), bf_hi(yv[r][j].y)}; ((f32x4*)xout[r])[lane + 64 * j] = v[r][j]; }
            s += (v[r][j].x * v[r][j].x + v[r][j].y * v[r][j].y) + (v[r][j].z * v[r][j].z + v[r][j].w * v[r][j].w); }
        const float rs = rsqrtf(wave_sum(s) * (1.f / D) + EPS);
#pragma unroll
        for (int j = 0; j < 4; ++j) { const f32x4 s1 = ((const f32x4*)mpsc[r])[lane + 64 * j], s0 = ((const f32x4*)mpsh[r])[lane + 64 * j];
            v[r][j] = v[r][j] * rs * gg[j] * (1.f + s1) + s0;
            const u32x2 pk = (u32x2){cvt_pk_bf16(v[r][j].x, v[r][j].y), cvt_pk_bf16(v[r][j].z, v[r][j].w)};
            if (TO_LDS) lrow[r][lane + 64 * j] = pk; else *((u32x2*)orow[r] + lane + 64 * j) = pk; }
    }
}
struct RowRegs { f32x4 x[4]; u32x2 y[4]; };
template <bool RES>
__device__ __forceinline__ void load_row(RowRegs& R, const float* xin, const bf16_t* yrow, int lane) {
#pragma unroll
    for (int j = 0; j < 4; ++j) { R.x[j] = ((const f32x4*)xin)[lane + 64 * j]; if (RES) R.y[j] = ((const u32x2*)yrow)[lane + 64 * j]; }
}
template <bool RES, bool TO_LDS>
__device__ __forceinline__ void finish_row(RowRegs& R, const float* gate, float* xout, const f32x4 (&gg)[4], const float* sh, const float* sc, bf16_t* orow, LAS u32x2* lrow, int lane) {
    float s = 0.f;
#pragma unroll
    for (int j = 0; j < 4; ++j) {
        if (RES) { const f32x4 gt = ((const f32x4*)gate)[lane + 64 * j]; R.x[j] = R.x[j] + gt * (f32x4){bf_lo(R.y[j].x), bf_hi(R.y[j].x), bf_lo(R.y[j].y), bf_hi(R.y[j].y)}; ((f32x4*)xout)[lane + 64 * j] = R.x[j]; }
        s += (R.x[j].x * R.x[j].x + R.x[j].y * R.x[j].y) + (R.x[j].z * R.x[j].z + R.x[j].w * R.x[j].w); }
    const float rs = rsqrtf(wave_sum(s) * (1.f / D) + EPS);
#pragma unroll
    for (int j = 0; j < 4; ++j) { const f32x4 s1 = ((const f32x4*)sc)[lane + 64 * j], s0 = ((const f32x4*)sh)[lane + 64 * j];
        R.x[j] = R.x[j] * rs * gg[j] * (1.f + s1) + s0;
        const u32x2 pk = (u32x2){cvt_pk_bf16(R.x[j].x, R.x[j].y), cvt_pk_bf16(R.x[j].z, R.x[j].w)};
        if (TO_LDS) lrow[lane + 64 * j] = pk; else *((u32x2*)orow + lane + 64 * j) = pk; }
}
__device__ __forceinline__ void ctx_row_part(const float* xin, float* xout, const float* part, int S, int r, const float* gate, const float* g, const float* sh, const float* sc, bf16_t* orow, int lane) {
    f32x4 v[4], y[4];
#pragma unroll
    for (int j = 0; j < 4; ++j) { v[j] = ((const f32x4*)xin)[lane + 64 * j]; y[j] = (f32x4){0.f, 0.f, 0.f, 0.f}; }
    for (int s = 0; s < S; ++s) { const f32x4* pp = (const f32x4*)(part + ((size_t)s * MC + r) * D);
#pragma unroll
        for (int j = 0; j < 4; ++j) y[j] += pp[lane + 64 * j]; }
    float ss = 0.f;
#pragma unroll
    for (int j = 0; j < 4; ++j) { v[j] = v[j] + ((const f32x4*)gate)[lane + 64 * j] * y[j]; ((f32x4*)xout)[lane + 64 * j] = v[j]; ss += (v[j].x * v[j].x + v[j].y * v[j].y) + (v[j].z * v[j].z + v[j].w * v[j].w); }
    const float rs = rsqrtf(wave_sum(ss) * (1.f / D) + EPS);
#pragma unroll
    for (int j = 0; j < 4; ++j) { const f32x4 o = v[j] * rs * ((const f32x4*)g)[lane + 64 * j] * (1.f + ((const f32x4*)sc)[lane + 64 * j]) + ((const f32x4*)sh)[lane + 64 * j];
        *((u32x2*)orow + lane + 64 * j) = (u32x2){cvt_pk_bf16(o.x, o.y), cvt_pk_bf16(o.z, o.w)}; }
}
__device__ __forceinline__ const float* xrow_ptr(const Frame& F, int row) { return row < ML ? F.a->out + (size_t)row * D : (const float*)(F.ws + WS_XC) + (size_t)(row - ML) * D; }

__device__ __forceinline__ void lt_expand(Frame& F, int first, int stride) {
    const Args& a = *F.a; unsigned char* ws = F.ws; const int lane = F.lane;
    const float* KK = (const float*)(ws + WS_KKER);
    for (int it = first; it < 64 * TCH; it += stride) {
        const int g = it / TCH, t = it % TCH;
        bf16_t* base = (bf16_t*)(ws + WS_LT) + ((size_t)g * 512 + t * 16) * SKA;
        const int s = lane >> 1, i0 = (lane & 1) * 8;
        const int sdir = lane >> 5, scomp = (lane >> 4) & 1, p0 = 4 * (lane & 15);
        f32x2 ap[4];
#pragma unroll
        for (int j = 0; j < 4; ++j) { const f32x2 ad = s5_adt(a, g, sdir, p0 + j); ap[j] = cpow(ad.x, ad.y, (float)(sdir ? TCH - t : t + 1)); }
        const float mf = (t >= s) ? 1.f : 0.f, mr = (t <= s) ? 1.f : 0.f; const int df = t >= s ? t - s : 0, dr = s >= t ? s - t : 0;
        const float* kf0 = KK + ((size_t)((g * 2 + 0) * 16) * TCH + df) * 16 + i0; const float* kr0 = KK + ((size_t)((g * 2 + 1) * 16) * TCH + dr) * 16 + i0;
        const float* cre0 = a.in[I_cre] + (size_t)((sdir * 64 + g) * 16) * 64 + p0; const float* cim0 = a.in[I_cim] + (size_t)((sdir * 64 + g) * 16) * 64 + p0;
        for (int ob = 0; ob < 16; ob += 4) {
            f32x4 a0[4], a1[4], b0[4], b1[4], cr4[4], ci4[4];
#pragma unroll
            for (int k = 0; k < 4; ++k) { const int o = ob + k; a0[k] = *(const f32x4*)(kf0 + o * TCH * 16); a1[k] = *(const f32x4*)(kf0 + o * TCH * 16 + 4); b0[k] = *(const f32x4*)(kr0 + o * TCH * 16); b1[k] = *(const f32x4*)(kr0 + o * TCH * 16 + 4);
                cr4[k] = *(const f32x4*)(cre0 + o * 64); ci4[k] = *(const f32x4*)(cim0 + o * 64); }
#pragma unroll
            for (int k = 0; k < 4; ++k) { const int o = ob + k;
                const f32x4 lo = mf * a0[k] + mr * b0[k], hi = mf * a1[k] + mr * b1[k];
                bf16_t* rowp = base + (size_t)o * SKA;
                *(u32x4*)(rowp + s * 16 + i0) = (u32x4){cvt_pk_bf16(lo.x, lo.y), cvt_pk_bf16(lo.z, lo.w), cvt_pk_bf16(hi.x, hi.y), cvt_pk_bf16(hi.z, hi.w)};
                float w[4];
#pragma unroll
                for (int j = 0; j < 4; ++j) { const float cr = cr4[k][j], ci = ci4[k][j]; w[j] = scomp ? -(cr * ap[j].y + ci * ap[j].x) : (cr * ap[j].x - ci * ap[j].y); }
                *(u32x2*)(rowp + SK + 4 * lane) = (u32x2){cvt_pk_bf16(w[0], w[1]), cvt_pk_bf16(w[2], w[3])}; }
        }
    }
}

__device__ __forceinline__ void p1_phase(Frame& F) {
    const Args& a = *F.a; unsigned char* ws = F.ws; const int gw = F.vcu * NWAVES + F.wave, NGW = F.G * NWAVES, lane = F.lane;
    const float* modp = (const float*)(ws + WS_MODP);
    if (F.wait_adaln) {
        if (F.tid == 0) { unsigned* cnt = (unsigned*)(ws + WS_CTL + CTL_ADALN); unsigned sp = 0;
            while (__hip_atomic_load(cnt, __ATOMIC_RELAXED, __HIP_MEMORY_SCOPE_AGENT) < 192u) { __builtin_amdgcn_s_sleep(2); if (++sp > (1u << 20)) break; }
            __builtin_amdgcn_fence(__ATOMIC_ACQUIRE, "agent"); asm volatile("s_waitcnt vmcnt(0)" ::: "memory"); }
        __syncthreads();
    }
    for (int row0 = gw; row0 < MT; row0 += 3 * NGW) {
        const float* xr[3]; const float* sh[3]; const float* sc[3]; bf16_t* orow[3]; f32x4 v[3][4];
#pragma unroll
        for (int r = 0; r < 3; ++r) { const int row = row0 + r * NGW; const bool ok = row < MT; const int rw = ok ? row : 0;
            xr[r] = ok ? (rw < ML ? a.in[I_x] + (size_t)rw * D : a.in[I_ctx] + (size_t)(rw - ML) * D) : nullptr; const float* mp = modp + (size_t)cond_of_row(rw) * 6144; sh[r] = mp; sc[r] = mp + 1024; orow[r] = (bf16_t*)(ws + WS_HB) + (size_t)rw * D; }
        const bf16_t* yn[3] = {nullptr, nullptr, nullptr}; const float* gn[3] = {nullptr, nullptr, nullptr}; float* xo[3] = {nullptr, nullptr, nullptr};
        modulate_rows<3, false>(xr, yn, gn, xo, a.in[I_n1g], sh, sc, orow, lane, v);
    }
#ifndef LT_IN_P1
#define LT_IN_P1 0
#endif
    if (!F.tailconv || LT_IN_P1) lt_expand(F, gw, NGW);
}
}
namespace fp {
using pg8::Unit;
typedef f32x4 Acc[2][2][4][2];
#ifndef WT_STORE
#define WT_STORE 0
#endif
__device__ __forceinline__ void st16(bf16_t* base, size_t elem_off, u32x4 v, __amdgpu_buffer_rsrc_t rs) {
    if (WT_STORE) __builtin_amdgcn_raw_buffer_store_b128(v, rs, (int)(unsigned)(elem_off * 2), 0, 16); else *(u32x4*)(base + elem_off) = v; }
__device__ __forceinline__ __amdgpu_buffer_rsrc_t mk_rsrc(const void* p, unsigned nbytes) { return __builtin_amdgcn_make_buffer_rsrc((void*)p, (short)0, (int)nbytes, 0x00020000); }
#define EPI_ROWS_BEGIN _Pragma("unroll") for (int ai = 0; ai < 2; ++ai) _Pragma("unroll") for (int m = 0; m < 4; ++m) { const int tr = 128 * ai + 64 * wr + 16 * m + fr;
#define EPI_ROWS_END }

struct SchedPlain {
    pg8::Order o; const bf16_t* A; const bf16_t* Bt; int lda, ldb, nt;
    __device__ __forceinline__ int ktiles(const Unit&) const { return nt; }
    __device__ __forceinline__ bool next(int i, Unit& u) const { return o.next(i, u); }
    __device__ __forceinline__ const char* aptr(const Unit& u) const { return (const char*)(A + (size_t)u.pm * 256 * lda); }
    __device__ __forceinline__ const char* bptr(const Unit& u) const { return (const char*)(Bt + (size_t)u.pn * 256 * ldb); }
};

struct EpiInProj {
    bf16_t* P; float* ssq; bf16_t* Kf; const LAS f32x2* rope;
    __device__ __forceinline__ void operator()(const Acc& acc, const Unit& u, int wr, int wc, int fr, int fq) const {
        EPI_ROWS_BEGIN
            const int row = u.pm * 256 + tr;
#pragma unroll
            for (int bj = 0; bj < 2; ++bj) {
                const int col8 = u.pn * 256 + 128 * bj + 32 * wc + 8 * fq;
                const f32x4 v0 = acc[ai][bj][m][0], v1 = acc[ai][bj][m][1];
                *(u32x4*)(P + (size_t)row * NIN + col8) = (u32x4){cvt_pk_bf16(v0[0], v0[1]), cvt_pk_bf16(v0[2], v0[3]), cvt_pk_bf16(v1[0], v1[1]), cvt_pk_bf16(v1[2], v1[3])};
                const int cb = u.pn * 2 + bj;
                if (cb < 5) {
                    float s = (v0[0] * v0[0] + v0[1] * v0[1]) + (v0[2] * v0[2] + v0[3] * v0[3]) + (v1[0] * v1[0] + v1[1] * v1[1]) + (v1[2] * v1[2] + v1[3] * v1[3]);
                    s += __shfl_xor(s, 16); s += __shfl_xor(s, 32);
                    if (fq == 0) ssq[(size_t)row * 20 + cb * 4 + wc] = s;
                } else if (cb == 5 && wc == 0) {
                    float x[8] = {v0[0], v0[1], v0[2], v0[3], v1[0], v1[1], v1[2], v1[3]};
                    if (row < ML) { const int t = row & (SEQ - 1), gr = t >> 6, gc = t & 63;
#pragma unroll
                        for (int e = 0; e < 4; ++e) { const int pi = 4 * fq + e; const f32x2 cs = rope[(pi < 8 ? gr : gc) * 8 + (pi & 7)]; const float x1 = x[2 * e], x2 = x[2 * e + 1]; x[2 * e] = x1 * cs.x - x2 * cs.y; x[2 * e + 1] = x1 * cs.y + x2 * cs.x; } }
                    const u32x4 w = (u32x4){cvt_pk_bf16(x[0], x[1]), cvt_pk_bf16(x[2], x[3]), cvt_pk_bf16(x[4], x[5]), cvt_pk_bf16(x[6], x[7])};
#pragma unroll
                    for (int h = 0; h < 8; ++h) *(u32x4*)(Kf + (size_t)row * 768 + h * 96 + 64 + 8 * fq) = w;
                }
            }
        EPI_ROWS_END
    }
};
struct EpiQb {
    bf16_t* Q; const float* ssq; const LAS f32x2* rope;
    __device__ __forceinline__ void operator()(const Acc& acc, const Unit& u, int wr, int wc, int fr, int fq) const {
        EPI_ROWS_BEGIN
            const int row = u.pm * 256 + tr; const f32x4 q0 = *(const f32x4*)(ssq + (size_t)row * 20), q1 = *(const f32x4*)(ssq + (size_t)row * 20 + 4), q2 = *(const f32x4*)(ssq + (size_t)row * 20 + 8);
            const float rs = rsqrtf((((q0[0] + q0[1]) + (q0[2] + q0[3])) + ((q1[0] + q1[1]) + (q1[2] + q1[3])) + ((q2[0] + q2[1]) + (q2[2] + q2[3]))) * (1.f / 384.f) + EPS) * C2_MLA;
            const int t = row & (SEQ - 1), gr = t >> 6, gc = t & 63;
#pragma unroll
            for (int bj = 0; bj < 2; ++bj) {
                const int col8 = u.pn * 256 + 128 * bj + 32 * wc + 8 * fq; const int d0 = col8 % 96;
                const f32x4 v0 = acc[ai][bj][m][0] * rs, v1 = acc[ai][bj][m][1] * rs;
                float x[8] = {v0[0], v0[1], v0[2], v0[3], v1[0], v1[1], v1[2], v1[3]};
                if (d0 >= 64 && row < ML) { const int pb = (d0 - 64) >> 1;
#pragma unroll
                    for (int e = 0; e < 4; ++e) { const int pi = pb + e; const f32x2 cs = rope[(pi < 8 ? gr : gc) * 8 + (pi & 7)]; const float x1 = x[2 * e], x2 = x[2 * e + 1]; x[2 * e] = x1 * cs.x - x2 * cs.y; x[2 * e + 1] = x1 * cs.y + x2 * cs.x; } }
                *(u32x4*)(Q + (size_t)row * 768 + col8) = (u32x4){cvt_pk_bf16(x[0], x[1]), cvt_pk_bf16(x[2], x[3]), cvt_pk_bf16(x[4], x[5]), cvt_pk_bf16(x[6], x[7])};
            }
        EPI_ROWS_END
    }
};
struct EpiKvb {
    bf16_t* Kf; bf16_t* V; const float* ssq;
    __device__ __forceinline__ void operator()(const Acc& acc, const Unit& u, int wr, int wc, int fr, int fq) const {
        EPI_ROWS_BEGIN
            const int row = u.pm * 256 + tr; const f32x4 q0 = *(const f32x4*)(ssq + (size_t)row * 20 + 12), q1 = *(const f32x4*)(ssq + (size_t)row * 20 + 16);
            const float rs = rsqrtf((((q0[0] + q0[1]) + (q0[2] + q0[3])) + ((q1[0] + q1[1]) + (q1[2] + q1[3]))) * (1.f / 256.f) + EPS);
#pragma unroll
            for (int bj = 0; bj < 2; ++bj) {
                const int col8 = u.pn * 256 + 128 * bj + 32 * wc + 8 * fq; const int h = col8 >> 7, d0 = col8 & 127;
                const f32x4 v0 = acc[ai][bj][m][0] * rs, v1 = acc[ai][bj][m][1] * rs;
                const u32x4 w = (u32x4){cvt_pk_bf16(v0[0], v0[1]), cvt_pk_bf16(v0[2], v0[3]), cvt_pk_bf16(v1[0], v1[1]), cvt_pk_bf16(v1[2], v1[3])};
                if (d0 < 64) *(u32x4*)(Kf + (size_t)row * 768 + h * 96 + d0) = w; else *(u32x4*)(V + (size_t)row * 512 + h * 64 + (d0 - 64)) = w;
            }
        EPI_ROWS_END
    }
};
struct EpiResid {
    const float* xin_l; const float* xin_c; float* xout_l; float* xout_c; const float* gate;
    __device__ __forceinline__ void operator()(const Acc& acc, const Unit& u, int wr, int wc, int fr, int fq) const {
        const bool lat = u.pm < 64; const float* xin = lat ? xin_l + (size_t)u.pm * 256 * D : xin_c + (size_t)(u.pm - 64) * 256 * D; float* xout = lat ? xout_l + (size_t)u.pm * 256 * D : xout_c + (size_t)(u.pm - 64) * 256 * D;
        const float* gt = gate + (size_t)cond_of_tile(u.pm) * 6144;
#pragma unroll
        for (int bj = 0; bj < 2; ++bj) {
            const int col8 = u.pn * 256 + 128 * bj + 32 * wc + 8 * fq; const f32x4 g0 = *(const f32x4*)(gt + col8), g1 = *(const f32x4*)(gt + col8 + 4);
            EPI_ROWS_BEGIN
                const size_t off = (size_t)tr * D + col8; const f32x4 x0 = *(const f32x4*)(xin + off), x1 = *(const f32x4*)(xin + off + 4);
                *(f32x4*)(xout + off) = x0 + g0 * acc[ai][bj][m][0]; *(f32x4*)(xout + off + 4) = x1 + g1 * acc[ai][bj][m][1];
            EPI_ROWS_END
        }
    }
};
struct EpiSwiglu {
    bf16_t* O; int ldo; int ncol_tiles; unsigned nbytes;
    __device__ __forceinline__ void operator()(const Acc& acc, const Unit& u, int wr, int wc, int fr, int fq) const {
        const int col8 = (u.pn % ncol_tiles) * 128 + 32 * wc + 8 * fq; const __amdgpu_buffer_rsrc_t rs = mk_rsrc(O, nbytes);
        EPI_ROWS_BEGIN
            const size_t row = (size_t)u.pm * 256 + tr; float o[8];
#pragma unroll
            for (int n = 0; n < 2; ++n)
#pragma unroll
                for (int j = 0; j < 4; ++j) { const float g = acc[ai][0][m][n][j], up = acc[ai][1][m][n][j]; o[4 * n + j] = g * fast_sigmoid(g) * up; }
            st16(O, row * ldo + col8, (u32x4){cvt_pk_bf16(o[0], o[1]), cvt_pk_bf16(o[2], o[3]), cvt_pk_bf16(o[4], o[5]), cvt_pk_bf16(o[6], o[7])}, rs);
        EPI_ROWS_END
    }
};
struct EpiS5In {
    bf16_t* acat; bf16_t* acatc;
    __device__ __forceinline__ void operator()(const Acc& acc, const Unit& u, int wr, int wc, int fr, int fq) const {
        EPI_ROWS_BEGIN
            const int row = u.pm * 256 + tr;
#pragma unroll
            for (int bj = 0; bj < 2; ++bj) {
                const int col8 = u.pn * 256 + 128 * bj + 32 * wc + 8 * fq; const int g = col8 >> 4, i0 = col8 & 15;
                const f32x4 v0 = acc[ai][bj][m][0], v1 = acc[ai][bj][m][1];
                const u32x4 w = (u32x4){cvt_pk_bf16(v0[0], v0[1]), cvt_pk_bf16(v0[2], v0[3]), cvt_pk_bf16(v1[0], v1[1]), cvt_pk_bf16(v1[2], v1[3])};
                if (row < ML) *(u32x4*)(acat + ((size_t)g * 512 + (row >> 5)) * SKA + (row & 31) * 16 + i0) = w;
                else { const int j = row - ML; *(u32x4*)(acatc + ((size_t)g * 32 + (j >> 5)) * SKA + (j & 31) * 16 + i0) = w; }
            }
        EPI_ROWS_END
    }
};
struct SchedSloc {
    pg8::Order o; const bf16_t* acat; const bf16_t* acatc; const bf16_t* bhat;
    __device__ __forceinline__ int ktiles(const Unit&) const { return SK / 64; }
    __device__ __forceinline__ bool next(int i, Unit& u) const { return o.next(i, u); }
    __device__ __forceinline__ const char* aptr(const Unit& u) const { const int g = u.pm / 3, rt = u.pm % 3; return (const char*)(rt < 2 ? acat + ((size_t)g * 512 + rt * 256) * SKA : acatc + (size_t)g * 32 * SKA); }
    __device__ __forceinline__ const char* bptr(const Unit& u) const { return (const char*)(bhat + (size_t)(u.pm / 3) * 256 * SK); }
};
struct EpiSloc {
    float* sloc;
    __device__ __forceinline__ void operator()(const Acc& acc, const Unit& u, int wr, int wc, int fr, int fq) const {
        const int g = u.pm / 3, rt = u.pm % 3;
        EPI_ROWS_BEGIN
            if (rt < 2 || tr < 32) {
                float* rp = sloc + ((size_t)g * 544 + rt * 256 + tr) * 256;
#pragma unroll
                for (int bj = 0; bj < 2; ++bj) { const int col8 = 128 * bj + 32 * wc + 8 * fq; *(f32x4*)(rp + col8) = acc[ai][bj][m][0]; *(f32x4*)(rp + col8 + 4) = acc[ai][bj][m][1]; }
            }
        EPI_ROWS_END
    }
};
struct SchedS5Out {
    pg8::Order o; const bf16_t* acat; const bf16_t* lt;
    __device__ __forceinline__ int ktiles(const Unit&) const { return SKA / 64; }
    __device__ __forceinline__ bool next(int i, Unit& u) const { return o.next(i, u); }
    __device__ __forceinline__ const char* aptr(const Unit& u) const { return (const char*)(acat + ((size_t)(u.pm >> 1) * 512 + (u.pm & 1) * 256) * SKA); }
    __device__ __forceinline__ const char* bptr(const Unit& u) const { return (const char*)(lt + ((size_t)(u.pm >> 1) * 512 + u.pn * 256) * SKA); }
};
__device__ __forceinline__ float gelu_tanh_fast(float x) { const float uu = 0.7978845608028654f * (x + 0.044715f * x * x * x); return x * __builtin_amdgcn_rcpf(1.f + __builtin_amdgcn_exp2f(-2.f * LOG2E * uu)); }
struct EpiS5Out {
    const bf16_t* acat; const float* dskip; bf16_t* gb;
    __device__ __forceinline__ void operator()(const Acc& acc, const Unit& u, int wr, int wc, int fr, int fq) const {
        const int g = u.pm >> 1, rm = u.pm & 1;
        f32x4 dd[2][2];
#pragma unroll
        for (int bj = 0; bj < 2; ++bj) { const int o0 = (u.pn * 256 + 128 * bj + 32 * wc + 8 * fq) & 15; dd[bj][0] = *(const f32x4*)(dskip + g * 16 + o0); dd[bj][1] = *(const f32x4*)(dskip + g * 16 + o0 + 4); }
#pragma unroll
        for (int ai = 0; ai < 2; ++ai) {
            u32x4 uw[4][2];
#pragma unroll
            for (int m = 0; m < 4; ++m)
#pragma unroll
                for (int bj = 0; bj < 2; ++bj) { const int R = rm * 256 + 128 * ai + 64 * wr + 16 * m + fr, n8 = u.pn * 256 + 128 * bj + 32 * wc + 8 * fq; uw[m][bj] = *(const u32x4*)(acat + ((size_t)g * 512 + R) * SKA + n8); }
#pragma unroll
            for (int m = 0; m < 4; ++m) { const int R = rm * 256 + 128 * ai + 64 * wr + 16 * m + fr;
#pragma unroll
                for (int bj = 0; bj < 2; ++bj) {
                    const int n8 = u.pn * 256 + 128 * bj + 32 * wc + 8 * fq; const int t = n8 >> 4, o0 = n8 & 15;
                    const u32x4 w = uw[m][bj]; const f32x4 d0 = dd[bj][0], d1 = dd[bj][1];
                    const f32x4 v0 = acc[ai][bj][m][0], v1 = acc[ai][bj][m][1];
                    float y[8] = {v0[0] + d0[0] * bf_lo(w.x), v0[1] + d0[1] * bf_hi(w.x), v0[2] + d0[2] * bf_lo(w.y), v0[3] + d0[3] * bf_hi(w.y),
                                  v1[0] + d1[0] * bf_lo(w.z), v1[1] + d1[1] * bf_hi(w.z), v1[2] + d1[2] * bf_lo(w.w), v1[3] + d1[3] * bf_hi(w.w)};
#pragma unroll
                    for (int j = 0; j < 8; ++j) y[j] = gelu_tanh_fast(y[j]);
                    *(u32x4*)(gb + ((size_t)R * 32 + t) * D + g * 16 + o0) = (u32x4){cvt_pk_bf16(y[0], y[1]), cvt_pk_bf16(y[2], y[3]), cvt_pk_bf16(y[4], y[5]), cvt_pk_bf16(y[6], y[7])};
                }
            }
        }
    }
};
struct EpiGlu {
    bf16_t* y;
    __device__ __forceinline__ void operator()(const Acc& acc, const Unit& u, int wr, int wc, int fr, int fq) const {
        const int col8 = u.pn * 128 + 32 * wc + 8 * fq;
        EPI_ROWS_BEGIN
            float o[8];
#pragma unroll
            for (int j = 0; j < 4; ++j) { o[j] = acc[ai][0][m][0][j] * fast_sigmoid(acc[ai][1][m][0][j]); o[4 + j] = acc[ai][0][m][1][j] * fast_sigmoid(acc[ai][1][m][1][j]); }
            *(u32x4*)(y + ((size_t)u.pm * 256 + tr) * D + col8) = (u32x4){cvt_pk_bf16(o[0], o[1]), cvt_pk_bf16(o[2], o[3]), cvt_pk_bf16(o[4], o[5]), cvt_pk_bf16(o[6], o[7])};
        EPI_ROWS_END
    }
};
struct SchedMoe {
    pg8::Order o; const bf16_t* A; const bf16_t* W; int lda; int ldb; int nrows_e;
    const LAS int* tile_e; int nt;
    __device__ __forceinline__ int ktiles(const Unit&) const { return nt; }
    __device__ __forceinline__ bool next(int i, Unit& u) const { return o.next(i, u); }
    __device__ __forceinline__ const char* aptr(const Unit& u) const { return (const char*)(A + (size_t)u.pm * 256 * lda); }
    __device__ __forceinline__ const char* bptr(const Unit& u) const { return (const char*)(W + ((size_t)tile_e[u.pm] * nrows_e + (size_t)u.pn * 256) * ldb); }
};
struct EpiBf16Store {
    bf16_t* O; int ldo;
    __device__ __forceinline__ void operator()(const Acc& acc, const Unit& u, int wr, int wc, int fr, int fq) const {
        EPI_ROWS_BEGIN
            const size_t row = (size_t)u.pm * 256 + tr;
#pragma unroll
            for (int bj = 0; bj < 2; ++bj) { const int col8 = u.pn * 256 + 128 * bj + 32 * wc + 8 * fq; const f32x4 v0 = acc[ai][bj][m][0], v1 = acc[ai][bj][m][1];
                *(u32x4*)(O + row * ldo + col8) = (u32x4){cvt_pk_bf16(v0[0], v0[1]), cvt_pk_bf16(v0[2], v0[3]), cvt_pk_bf16(v1[0], v1[1]), cvt_pk_bf16(v1[2], v1[3])}; }
        EPI_ROWS_END
    }
};
struct SchedCtxSplit {
    pg8::Order o; const bf16_t* A; const bf16_t* Bt; int lda, ldb, ntfull, S, G, c;
    __device__ __forceinline__ bool next(int i, Unit& u) const {
        const int L = i * G + c;
        if (L < 256) { o.map(L, u); return true; }
        const int j = L - 256; if (j >= 16 * S) return false;
        const int t = j / S; u.ks = j % S; u.pm = 64 + (t >> 2); u.pn = t & 3; return true; }
    __device__ __forceinline__ int ktiles(const Unit& u) const { return u.ks < 0 ? ntfull : ntfull / S; }
    __device__ __forceinline__ const char* aptr(const Unit& u) const { return (const char*)(A + (size_t)u.pm * 256 * lda + (u.ks < 0 ? 0 : u.ks * (ntfull / S) * 64)); }
    __device__ __forceinline__ const char* bptr(const Unit& u) const { return (const char*)(Bt + (size_t)u.pn * 256 * ldb + (u.ks < 0 ? 0 : u.ks * (ntfull / S) * 64)); }
};
struct EpiBf16OrPart {
    bf16_t* O; int ldo; float* part; int row0, nrows;
    __device__ __forceinline__ void operator()(const Acc& acc, const Unit& u, int wr, int wc, int fr, int fq) const {
        EPI_ROWS_BEGIN
            const size_t row = (size_t)u.pm * 256 + tr;
#pragma unroll
            for (int bj = 0; bj < 2; ++bj) { const int col8 = u.pn * 256 + 128 * bj + 32 * wc + 8 * fq; const f32x4 v0 = acc[ai][bj][m][0], v1 = acc[ai][bj][m][1];
                if (u.ks < 0) *(u32x4*)(O + row * ldo + col8) = (u32x4){cvt_pk_bf16(v0[0], v0[1]), cvt_pk_bf16(v0[2], v0[3]), cvt_pk_bf16(v1[0], v1[1]), cvt_pk_bf16(v1[2], v1[3])};
                else { float* pp = part + ((size_t)u.ks * nrows + (row - row0)) * D + col8; *(f32x4*)pp = v0; *(f32x4*)(pp + 4) = v1; } }
        EPI_ROWS_END
    }
};
struct SchedMoeD {
    pg8::Order o; const bf16_t* A; const bf16_t* W; int lda, ldb, ntfull, S, G, c, RT, NT; const LAS int* tile_e;
    __device__ __forceinline__ bool next(int i, Unit& u) const {
        const int L = i * G + c;
        if (L < RT * 4) { o.map(L, u); return true; }
        const int j = L - RT * 4; if (j >= (NT - RT) * 4 * S) return false;
        const int t = j / S; u.ks = (S > 1) ? j % S : -1; u.pm = RT + (t >> 2); u.pn = t & 3; return true; }
    __device__ __forceinline__ int ktiles(const Unit& u) const { return u.ks < 0 ? ntfull : ntfull / S; }
    __device__ __forceinline__ const char* aptr(const Unit& u) const { return (const char*)(A + (size_t)u.pm * 256 * lda + (u.ks < 0 ? 0 : u.ks * (ntfull / S) * 64)); }
    __device__ __forceinline__ const char* bptr(const Unit& u) const { return (const char*)(W + ((size_t)tile_e[u.pm] * 1024 + (size_t)u.pn * 256) * ldb + (u.ks < 0 ? 0 : u.ks * (ntfull / S) * 64)); }
};
__device__ __forceinline__ void moe_split_plan(int NT, int G, int& RT, int& S) {
    RT = ((NT * 4) / G) * G / 4; const int rem = (NT - RT) * 4; S = (rem > 0 && rem * 7 <= G) ? 7 : ((rem > 0 && rem * 4 <= G) ? 4 : ((rem > 0 && rem * 2 <= G) ? 2 : 1));
    if (RT == 0) { RT = NT; S = 1; }
}
}
namespace fp {
template <int DQK> struct AttnCfg { static constexpr int KP = 2 * DQK + 16, KBYTES = 64 * KP, VBYTES = 8192, BUF = KBYTES + VBYTES, CK = DQK / 8, NKCH = 64 * CK; };
struct AttnArgs {
    const bf16_t* Q; int qp; const bf16_t* K; int kp; const bf16_t* V; int vp; bf16_t* O; int op;
    int qrow0;
    int k0row, nt0;
    int k1row, nt1;
    int gr0, krow0, window;
};
__device__ __forceinline__ int crow(int r, int hi) { return (r & 3) + 8 * (r >> 2) + 4 * hi; }
__device__ __forceinline__ s16x4 ds_tr(LAS const unsigned char* p) { typedef short v4i16_t __attribute__((ext_vector_type(4))); return __builtin_bit_cast(s16x4, __builtin_amdgcn_ds_read_tr16_b64_v4i16((LAS v4i16_t*)p)); }

__device__ __forceinline__ void glds16(const void* gsrc, unsigned lds_dst) { unsigned keep;
    asm volatile("s_mov_b32 %0, m0\n\ts_mov_b32 m0, %2\n\ts_nop 0\n\tglobal_load_lds_dwordx4 %1, off\n\ts_mov_b32 m0, %0" : "=&s"(keep) : "v"(gsrc), "s"(lds_dst) : "memory"); }
__device__ __forceinline__ float max3f(float a, float b, float c) { float r; asm("v_max3_f32 %0, %1, %2, %3" : "=v"(r) : "v"(a), "v"(b), "v"(c)); return r; }
template <int DQK, bool NAW, bool DEFER>
__device__ __forceinline__ void attn_body(LAS unsigned char* lds, const AttnArgs& A, const LAS float* bias) {
    typedef AttnCfg<DQK> C;
    constexpr int VOFF = 2 * C::KBYTES;
    const int tid = threadIdx.x, lane = tid & 63, w = __builtin_amdgcn_readfirstlane(tid >> 6), q = lane & 31, hi = lane >> 5;
    constexpr int ND = DQK / 16;
    bf16x8 qf[ND];
    { const bf16_t* qr = A.Q + (size_t)(A.qrow0 + 32 * w + q) * A.qp + 8 * hi;
#pragma unroll
      for (int d0 = 0; d0 < ND; ++d0) qf[d0] = *(const bf16x8*)(qr + 16 * d0); }
    const int NT = A.nt0 + A.nt1;
    const int kid0 = tid, kid1 = tid + 512; const bool has1 = kid1 < C::NKCH;
    const int kr0 = kid0 / C::CK, kc0 = kid0 % C::CK, kr1 = kid1 / C::CK, kc1 = kid1 % C::CK, vr = tid >> 3, vc = tid & 7;
    const unsigned kl0 = kr0 * C::KP + kc0 * 16, kl1 = kr1 * C::KP + kc1 * 16, vl = VOFF + (vc >> 2) * 4096 + vr * 64 + (vc & 3) * 16;
    u32x4 rk0, rk1, rv; rk1 = (u32x4){0u, 0u, 0u, 0u};
#define ATT_LOAD(t) do { const int rb_ = (t) < A.nt0 ? A.k0row + 64 * (t) : A.k1row + 64 * ((t) - A.nt0); \
        rk0 = *(const u32x4*)(A.K + (size_t)(rb_ + kr0) * A.kp + kc0 * 8); if (has1) rk1 = *(const u32x4*)(A.K + (size_t)(rb_ + kr1) * A.kp + kc1 * 8); \
        rv = *(const u32x4*)(A.V + (size_t)(rb_ + vr) * A.vp + vc * 8); } while (0)
#define ATT_WRITE(kslot, vslot) do { *(LAS u32x4*)(lds + (kslot) * C::KBYTES + kl0) = rk0; if (has1) *(LAS u32x4*)(lds + (kslot) * C::KBYTES + kl1) = rk1; *(LAS u32x4*)(lds + (vslot) * C::VBYTES + vl) = rv; } while (0)
    ATT_LOAD(0);
    __syncthreads();
    ATT_WRITE(0, 0);
    __syncthreads();
    float mrow = 0.f, lrow = 0.f; f32x16 o0 = {}, o1 = {}; f32x16 negm = {}; bool first = true;
    constexpr float THR = 8.f;
    const int gr = A.gr0 + (w >> 1), cq = 32 * (w & 1) + q;
    int rs = gr - 4; rs = rs < 0 ? 0 : (rs > 56 ? 56 : rs); int csq = cq - 8; csq = csq < 0 ? 0 : (csq > 48 ? 48 : csq);
    const int i16 = lane & 15, tq = i16 >> 2, tp = i16 & 3, blk = (lane >> 4) & 1;
    const unsigned voff = VOFF + (4 * hi + tq) * 64 + (16 * blk + 4 * tp) * 2;
    bf16x8 pb[2][2]; bool pend = false; int vs_prev = 0, vs_cur = 0, vs_next = 1;
#define ATT_PV(vslot) do { _Pragma("unroll") for (int kh = 0; kh < 2; ++kh) _Pragma("unroll") for (int s = 0; s < 2; ++s) { \
            LAS const unsigned char* vb = lds + (vslot) * C::VBYTES + voff + (32 * kh + 16 * s) * 64; \
            const s16x4 a0 = ds_tr(vb), a1 = ds_tr(vb + 8 * 64), c0 = ds_tr(vb + 4096), c1 = ds_tr(vb + 4096 + 8 * 64); \
            const bf16x8 va = (bf16x8){a0[0], a0[1], a0[2], a0[3], a1[0], a1[1], a1[2], a1[3]}, vc2 = (bf16x8){c0[0], c0[1], c0[2], c0[3], c1[0], c1[1], c1[2], c1[3]}; \
            o0 = __builtin_amdgcn_mfma_f32_32x32x16_bf16(va, pb[kh][s], o0, 0, 0, 0); \
            o1 = __builtin_amdgcn_mfma_f32_32x32x16_bf16(vc2, pb[kh][s], o1, 0, 0, 0); } } while (0)
    for (int t = 0; t < NT; ++t) {
        const int b = t & 1;
        if (t + 1 < NT) ATT_LOAD(t + 1);
        if (DEFER) { if (pend) { ATT_PV(vs_prev); pend = false; } }
        bool active = true; int krow = 0;
        if (NAW) { if (A.window && t < A.nt0) { krow = A.krow0 + t; active = (krow >= rs) && (krow < rs + 8); } }
        if (active) {
            LAS const unsigned char* kb = lds + b * C::KBYTES;
            f32x16 p0, p1;
#pragma unroll
            for (int d0 = 0; d0 < ND; ++d0) {
                const bf16x8 k0 = *(LAS const bf16x8*)(kb + q * C::KP + (16 * d0 + 8 * hi) * 2);
                const bf16x8 k1 = *(LAS const bf16x8*)(kb + (32 + q) * C::KP + (16 * d0 + 8 * hi) * 2);
                if (d0 == 0) { p0 = __builtin_amdgcn_mfma_f32_32x32x16_bf16(k0, qf[0], negm, 0, 0, 0); p1 = __builtin_amdgcn_mfma_f32_32x32x16_bf16(k1, qf[0], negm, 0, 0, 0); }
                else { p0 = __builtin_amdgcn_mfma_f32_32x32x16_bf16(k0, qf[d0], p0, 0, 0, 0); p1 = __builtin_amdgcn_mfma_f32_32x32x16_bf16(k1, qf[d0], p1, 0, 0, 0); }
            }
            if (NAW) { if (A.window && t < A.nt0) {
                const LAS float* brow = bias + (krow - gr + 7) * 31;
#pragma unroll
                for (int r = 0; r < 16; ++r) { const int ck0 = crow(r, hi), ck1 = 32 + ck0;
                    { const int dc = ck0 - csq; int bi = ck0 - cq + 15; bi = bi < 0 ? 0 : (bi > 30 ? 30 : bi); p0[r] = ((unsigned)dc < 16u) ? p0[r] + brow[bi] : -INFINITY; }
                    { const int dc = ck1 - csq; int bi = ck1 - cq + 15; bi = bi < 0 ? 0 : (bi > 30 ? 30 : bi); p1[r] = ((unsigned)dc < 16u) ? p1[r] + brow[bi] : -INFINITY; } }
            } }
            float ra = max3f(p0[0], p0[1], p1[0]), rb2 = max3f(p0[2], p0[3], p1[1]); ra = max3f(ra, p1[2], p1[3]);
#pragma unroll
            for (int r = 4; r < 16; r += 4) { ra = max3f(ra, p0[r], p0[r + 1]); rb2 = max3f(rb2, p0[r + 2], p0[r + 3]); ra = max3f(ra, p1[r], p1[r + 1]); rb2 = max3f(rb2, p1[r + 2], p1[r + 3]); }
            float rm = max3f(ra, rb2, rb2);
            { auto rr = __builtin_amdgcn_permlane32_swap(__float_as_uint(rm), __float_as_uint(rm), false, false); rm = max3f(__uint_as_float(rr[0]), __uint_as_float(rr[1]), __uint_as_float(rr[1])); }
            if (first || __any(rm > THR)) {
                const float delta = first ? rm : fmaxf(rm, 0.f), alpha = first ? 0.f : __builtin_amdgcn_exp2f(-delta);
                mrow += delta; lrow *= alpha;
#pragma unroll
                for (int r = 0; r < 16; ++r) { p0[r] -= delta; p1[r] -= delta; o0[r] *= alpha; o1[r] *= alpha; negm[r] = -mrow; }
                first = false;
            }
            float ls = 0.f;
#pragma unroll
            for (int r = 0; r < 16; ++r) { p0[r] = __builtin_amdgcn_exp2f(p0[r]); p1[r] = __builtin_amdgcn_exp2f(p1[r]); ls += p0[r] + p1[r]; }
            lrow += ls;
#pragma unroll
            for (int s = 0; s < 2; ++s) {
                pb[0][s] = __builtin_bit_cast(bf16x8, (u32x4){cvt_pk_bf16(p0[8 * s], p0[8 * s + 1]), cvt_pk_bf16(p0[8 * s + 2], p0[8 * s + 3]), cvt_pk_bf16(p0[8 * s + 4], p0[8 * s + 5]), cvt_pk_bf16(p0[8 * s + 6], p0[8 * s + 7])});
                pb[1][s] = __builtin_bit_cast(bf16x8, (u32x4){cvt_pk_bf16(p1[8 * s], p1[8 * s + 1]), cvt_pk_bf16(p1[8 * s + 2], p1[8 * s + 3]), cvt_pk_bf16(p1[8 * s + 4], p1[8 * s + 5]), cvt_pk_bf16(p1[8 * s + 6], p1[8 * s + 7])});
            }
            if (DEFER) pend = true; else ATT_PV(vs_cur);
        }
        if (t + 1 < NT) ATT_WRITE(b ^ 1, vs_next);
        __syncthreads();
        vs_prev = vs_cur; vs_cur = vs_next; vs_next = (vs_next == 2) ? 0 : vs_next + 1;
    }
    if (DEFER) { if (pend) ATT_PV(vs_prev); }
#undef ATT_PV
#undef ATT_LOAD
#undef ATT_WRITE
    { auto rr = __builtin_amdgcn_permlane32_swap(__float_as_uint(lrow), __float_as_uint(lrow), false, false); lrow = __uint_as_float(rr[0]) + __uint_as_float(rr[1]); }
    const float inv = 1.f / lrow;
    bf16_t* orow = A.O + (size_t)(A.qrow0 + 32 * w + q) * A.op;
#pragma unroll
    for (int rg = 0; rg < 4; ++rg) {
        *(u32x2*)(orow + 8 * rg + 4 * hi) = (u32x2){cvt_pk_bf16(o0[4 * rg] * inv, o0[4 * rg + 1] * inv), cvt_pk_bf16(o0[4 * rg + 2] * inv, o0[4 * rg + 3] * inv)};
        *(u32x2*)(orow + 32 + 8 * rg + 4 * hi) = (u32x2){cvt_pk_bf16(o1[4 * rg] * inv, o1[4 * rg + 1] * inv), cvt_pk_bf16(o1[4 * rg + 2] * inv, o1[4 * rg + 3] * inv)};
    }
}
template <int DQK, bool NAW>
__device__ __forceinline__ void attn_unit(LAS unsigned char* lds, const AttnArgs& A, const LAS float* bias) {
    if (__builtin_amdgcn_readfirstlane(threadIdx.x >> 8) == 0) attn_body<DQK, NAW, false>(lds, A, bias); else attn_body<DQK, NAW, true>(lds, A, bias);
}

__device__ __forceinline__ void p4_attention(Frame& F) {
    unsigned char* ws = F.ws; const Args& a = *F.a;
    const bf16_t* P = (const bf16_t*)(ws + WS_P); const bf16_t* Qb = (const bf16_t*)(ws + WS_Q); const bf16_t* Kf = (const bf16_t*)(ws + WS_KF); const bf16_t* Vb = (const bf16_t*)(ws + WS_V); bf16_t* AO = (bf16_t*)(ws + WS_AO);
#ifndef PROBE_PH
#define PROBE_PH -1
#endif
    for (int ii = 0; ii < ((PROBE_PH == 40) ? 5 : 3); ++ii) { const int i = (PROBE_PH == 40 && ii >= 3) ? ii - 3 : ii;
        AttnArgs A; A.gr0 = 0; A.krow0 = 0; A.window = 0;
        if (i < 2) { const int u = F.vcu * 2 + i; if (u >= 512) break; const int bh = u >> 4, qb = u & 15, b = bh >> 3, h = bh & 7;
            A.Q = Qb + h * 96; A.qp = 768; A.K = Kf + h * 96; A.kp = 768; A.V = Vb + h * 64; A.vp = 512; A.O = AO + h * 64; A.op = D;
            A.qrow0 = b * SEQ + qb * 256; A.k0row = b * SEQ; A.nt0 = SEQ / 64; A.k1row = ML + b * CTX; A.nt1 = CTX / 64; }
        else { if (F.vcu >= 32) break; const int b = F.vcu >> 3, h = F.vcu & 7;
            A.Q = Qb + h * 96; A.qp = 768; A.K = Kf + h * 96; A.kp = 768; A.V = Vb + h * 64; A.vp = 512; A.O = AO + h * 64; A.op = D;
            A.qrow0 = ML + b * CTX; A.k0row = ML + b * CTX; A.nt0 = CTX / 64; A.k1row = 0; A.nt1 = 0; }
        attn_unit<96, false>(F.lds, A, nullptr);
    }
    LAS float* bias = (LAS float*)(F.lds + LDS_BIAS);
    for (int ii = 0; ii < ((PROBE_PH == 41) ? 5 : 3); ++ii) { const int i = (PROBE_PH == 41 && ii >= 3) ? ii - 3 : ii;
        AttnArgs A; int h;
        if (i < 2) { const int u = F.vcu * 2 + i; if (u >= 512) break; const int bh = u >> 4, qb = u & 15, b = bh >> 3; h = bh & 7;
            const int gr0 = 4 * qb; int r0 = gr0 - 4; r0 = r0 < 0 ? 0 : (r0 > 56 ? 56 : r0); int r1 = gr0 + 3 - 4; r1 = r1 < 0 ? 0 : (r1 > 56 ? 56 : r1);
            A.qrow0 = b * SEQ + qb * 256; A.k0row = b * SEQ + r0 * 64; A.nt0 = r1 + 8 - r0; A.k1row = ML + b * CTX; A.nt1 = CTX / 64; A.gr0 = gr0; A.krow0 = r0; A.window = 1; }
        else { if (F.vcu < 32 || F.vcu >= 64) break; const int v = F.vcu - 32, b = v >> 3; h = v & 7;
            A.qrow0 = ML + b * CTX; A.k0row = ML + b * CTX; A.nt0 = CTX / 64; A.k1row = 0; A.nt1 = 0; A.gr0 = 0; A.krow0 = 0; A.window = 0; }
        A.Q = P + 672 + h * 64; A.qp = NIN; A.K = P + 1184 + h * 64; A.kp = NIN; A.V = P + 1696 + h * 64; A.vp = NIN; A.O = AO + 512 + h * 64; A.op = D;
        __syncthreads();
        if (F.tid < 465) bias[F.tid] = a.in[I_rpb][h * 465 + F.tid] * LOG2E;
        attn_unit<64, true>(F.lds, A, bias);
    }
}

__device__ __forceinline__ void p12_scan(Frame& F) {
    unsigned char* ws = F.ws; const Args& a = *F.a;
    const float* sloc = (const float*)(ws + WS_SLOC); bf16_t* acat = (bf16_t*)(ws + WS_ACAT);
    const int gwv = F.vcu * NWAVES + F.wave;
    if (gwv >= NB * 64 * 2) return;
    const int dir = gwv & 1, g = (gwv >> 1) & 63, b = gwv >> 7, p = F.lane;
    const f32x4 dsc = s5_disc(a, g, dir, p); const f32x2 aT = cpow(dsc.x, dsc.y, (float)TCH);
    float sr = 0.f, si = 0.f;
    const float* base = sloc + (size_t)g * 544 * 256 + dir * 128 + p;
    bf16_t* abase = acat + (size_t)g * 512 * SKA + SK + dir * 128 + p;
    {
        float lr[8], li[8];
#pragma unroll
        for (int j = 0; j < 8; ++j) { const int c = dir ? NCHC - 1 - j : j; const size_t R = 512 + b * NCHC + c; lr[j] = base[R * 256]; li[j] = base[R * 256 + 64]; }
#pragma unroll
        for (int j = 0; j < 8; ++j) { const float nr = aT.x * sr - aT.y * si + lr[j], ni = aT.x * si + aT.y * sr + li[j]; sr = nr; si = ni; }
    }
    for (int s0 = 0; s0 < NCH; s0 += 16) {
        float lr[16], li[16];
#pragma unroll
        for (int j = 0; j < 16; ++j) { const int c = dir ? NCH - 1 - (s0 + j) : s0 + j; const size_t R = b * NCH + c; lr[j] = base[R * 256]; li[j] = base[R * 256 + 64]; }
#pragma unroll
        for (int j = 0; j < 16; ++j) { const int c = dir ? NCH - 1 - (s0 + j) : s0 + j; const size_t R = b * NCH + c;
            bf16_t* ap = abase + R * SKA; ap[0] = (bf16_t)f2bf(sr); ap[64] = (bf16_t)f2bf(si);
            const float nr = aT.x * sr - aT.y * si + lr[j], ni = aT.x * si + aT.y * sr + li[j]; sr = nr; si = ni; }
    }
}

__device__ __forceinline__ void moe_tables(Frame& F) {
    LAS int* toff = (LAS int*)(F.lds + LDS_MOE); LAS int* te = toff + 16;
    __syncthreads();
    if (F.tid == 0) { const unsigned* cnt = (const unsigned*)(F.ws + WS_CTL + CTL_CNT); int acc = 0;
        for (int e = 0; e < NE; ++e) { toff[e] = acc; const int n = (int)((__hip_atomic_load(cnt + 64 * e, __ATOMIC_RELAXED, __HIP_MEMORY_SCOPE_AGENT) + 255u) >> 8); for (int j = 0; j < n; ++j) te[acc + j] = e; acc += n; }
        toff[NE] = acc; }
    __syncthreads();
}
#ifndef TSTAMP
#define TSTAMP -1
#endif
#ifndef TSPAN
#define TSPAN 1
#endif
#define FSTAMP(F, k) do { if (TSTAMP >= 0 && blockIdx.x == 0 && (F).tid == 0) { volatile LAS unsigned long long* tsl_ = (volatile LAS unsigned long long*)((F).lds + LDS_MISC + 128); if ((k) == TSTAMP) tsl_[0] = wall_clock64(); if ((k) == TSTAMP + TSPAN) tsl_[1] = wall_clock64(); } } while (0)
__device__ __forceinline__ void p15_route_gather(Frame& F) {
    unsigned char* ws = F.ws; const Args& a = *F.a; const int lane = F.lane;
    const float* mp1 = (const float*)(ws + WS_MODP) + 5 * 6144;
    LAS int* lcnt = (LAS int*)(F.lds + LDS_BIAS);
    LAS int* lrec = lcnt + 16;
    LAS float* lw = (LAS float*)(lrec + 256);
    LAS int* toff = (LAS int*)(F.lds + LDS_MOE); LAS int* te = toff + 16;
    if (F.tid < 16) lcnt[F.tid] = 0;
    __syncthreads();
    int* tok_r = (int*)(ws + WS_TOK); float* tok_w = (float*)(ws + WS_TOK + (size_t)ML * 8);
    f32x4 rw0[16], rw1[16];
#pragma unroll
    for (int j = 0; j < 4; ++j)
#pragma unroll
        for (int c = 0; c < 4; ++c) { const int k = 4 * (lane + 64 * j) + c; rw0[4 * j + c] = *(const f32x4*)(a.in[I_router] + (size_t)k * 8); rw1[4 * j + c] = *(const f32x4*)(a.in[I_router] + (size_t)k * 8 + 4); }
    for (int ib = 0; ib < 4; ++ib) {
        const float* xr[2]; const float* sh[2]; const float* sc[2]; bf16_t* orow[2]; f32x4 v[2][4]; int rows[2]; const bf16_t* yr[2]; const float* gt[2]; float* xo[2]; LAS u32x2* lrow[2];
#pragma unroll
        for (int r = 0; r < 2; ++r) { const int row = (F.vcu * NWAVES + F.wave) + (2 * ib + r) * F.G * NWAVES; const bool ok = row < ML; const int rw = ok ? row : 0; rows[r] = ok ? row : -1;
            xr[r] = ok ? a.out + (size_t)rw * D : nullptr; const float* mp = mp1 + (size_t)(rw / SEQ) * 6144; sh[r] = mp + 3 * 1024; sc[r] = mp + 4 * 1024; orow[r] = nullptr;
            yr[r] = (const bf16_t*)(ws + WS_Y3) + (size_t)rw * D; gt[r] = mp + 2 * 1024; xo[r] = a.out + (size_t)rw * D; lrow[r] = (LAS u32x2*)(F.lds + (F.wave * 8 + 2 * ib + r) * 2048); }
        modulate_rows<2, true, true>(xr, yr, gt, xo, a.in[I_n2g] + D, sh, sc, orow, lane, v, lrow);
#pragma unroll
        for (int r = 0; r < 2; ++r) if (rows[r] >= 0) {
            float lg[8] = {0.f, 0.f, 0.f, 0.f, 0.f, 0.f, 0.f, 0.f};
#pragma unroll
            for (int j = 0; j < 4; ++j)
#pragma unroll
                for (int c = 0; c < 4; ++c) { const f32x4 w0 = rw0[4 * j + c], w1 = rw1[4 * j + c]; const float tv = v[r][j][c];
                    lg[0] += tv * w0[0]; lg[1] += tv * w0[1]; lg[2] += tv * w0[2]; lg[3] += tv * w0[3]; lg[4] += tv * w1[0]; lg[5] += tv * w1[1]; lg[6] += tv * w1[2]; lg[7] += tv * w1[3]; }
#pragma unroll
            for (int e = 0; e < 8; ++e) lg[e] = wave_sum(lg[e]);
            if (lane == 0) {
                int i1 = 0; for (int e = 1; e < 8; ++e) if (lg[e] > lg[i1]) i1 = e;
                int i2 = -1; for (int e = 0; e < 8; ++e) if (e != i1 && (i2 < 0 || lg[e] > lg[i2])) i2 = e;
                const float e2 = expf(lg[i2] - lg[i1]), w1 = 1.f / (1.f + e2), w2 = e2 / (1.f + e2);
                const int li = F.wave * 8 + 2 * ib + r;
                lrec[li * 4 + 0] = i1; lrec[li * 4 + 1] = i2; lrec[li * 4 + 2] = __hip_atomic_fetch_add(lcnt + i1, 1, __ATOMIC_RELAXED, __HIP_MEMORY_SCOPE_WORKGROUP); lrec[li * 4 + 3] = __hip_atomic_fetch_add(lcnt + i2, 1, __ATOMIC_RELAXED, __HIP_MEMORY_SCOPE_WORKGROUP);
                lw[li * 2] = w1; lw[li * 2 + 1] = w2;
            }
        }
    }
    FSTAMP(F, 100);
    __syncthreads();
    unsigned* cnt = (unsigned*)(ws + WS_CTL + CTL_CNT); unsigned* done = (unsigned*)(ws + WS_CTL + CTL_DONE);
    if (F.tid < 8) lcnt[8 + F.tid] = (int)__hip_atomic_fetch_add(cnt + 64 * F.tid, (unsigned)lcnt[F.tid], __ATOMIC_RELAXED, __HIP_MEMORY_SCOPE_AGENT);
    __syncthreads();
    if (F.tid == 0) {
        (void)__hip_atomic_fetch_add(done, 1u, __ATOMIC_RELAXED, __HIP_MEMORY_SCOPE_AGENT);
        unsigned sp = 0; while (__hip_atomic_load(done, __ATOMIC_RELAXED, __HIP_MEMORY_SCOPE_AGENT) < (unsigned)F.G) { __builtin_amdgcn_s_sleep(2); if (++sp > (1u << 20)) break; }
        int acc = 0;
        for (int e = 0; e < NE; ++e) { toff[e] = acc; const int n = (int)((__hip_atomic_load(cnt + 64 * e, __ATOMIC_RELAXED, __HIP_MEMORY_SCOPE_AGENT) + 255u) >> 8); for (int j = 0; j < n; ++j) te[acc + j] = e; acc += n; }
        toff[NE] = acc;
    }
    __syncthreads();
    FSTAMP(F, 101);
    bf16_t* Xg = (bf16_t*)(ws + WS_XG);
    for (int i = 0; i < 8; ++i) { const int li = F.wave * 8 + i; const int row = (F.vcu * NWAVES + F.wave) + i * F.G * NWAVES; if (row >= ML) continue;
        const int e0 = lrec[li * 4], e1 = lrec[li * 4 + 1]; const size_t r0 = (size_t)toff[e0] * 256 + lcnt[8 + e0] + lrec[li * 4 + 2], r1 = (size_t)toff[e1] * 256 + lcnt[8 + e1] + lrec[li * 4 + 3];
        const LAS u32x4* src = (const LAS u32x4*)(F.lds + li * 2048); const u32x4 x0 = src[lane], x1 = src[lane + 64];
        u32x4* d0 = (u32x4*)(Xg + r0 * D); u32x4* d1 = (u32x4*)(Xg + r1 * D); d0[lane] = x0; d0[lane + 64] = x1; d1[lane] = x0; d1[lane + 64] = x1;
        if (lane == 0) { tok_r[row * 2] = (int)r0; tok_r[row * 2 + 1] = (int)r1; tok_w[row * 2] = lw[li * 2]; tok_w[row * 2 + 1] = lw[li * 2 + 1]; } }
    __syncthreads();
}
__device__ __forceinline__ void p19_final(Frame& F) {
    unsigned char* ws = F.ws; const Args& a = *F.a; const LAS int* toff = (const LAS int*)(F.lds + LDS_MOE); const int lane = F.lane;
    const int* tok_r = (const int*)(ws + WS_TOK); const float* tok_w = (const float*)(ws + WS_TOK + (size_t)ML * 8);
    const bf16_t* Yg = (const bf16_t*)(ws + WS_XG); const float* mp1 = (const float*)(ws + WS_MODP) + 5 * 6144;
    const int NGW = F.G * NWAVES; int RT, SS; moe_split_plan(toff[NE], F.G, RT, SS); const size_t prow0 = (size_t)RT * 256, pn = (size_t)(toff[NE] - RT) * 256;
    const float* part = (const float*)(ws + WS_PART18);
#ifndef TSTAMP
#define TSTAMP -1
#endif
    const float tscale = (TSTAMP >= 0) ? ((const float*)(ws + WS_CTL + CTL_TS))[0] : 1.f;
    for (int row0 = F.vcu * NWAVES + F.wave; row0 < ML; row0 += 2 * NGW) {
        f32x4 v[2][4], ya[2][4], yb[2][4]; float w0[2], w1[2]; bool ok[2];
#pragma unroll
        for (int r = 0; r < 2; ++r) { const int row = row0 + r * NGW; ok[r] = row < ML; if (ok[r]) {
            const size_t ra = (size_t)tok_r[row * 2], rb = (size_t)tok_r[row * 2 + 1]; w0[r] = tok_w[row * 2]; w1[r] = tok_w[row * 2 + 1];
#pragma unroll
            for (int j = 0; j < 4; ++j) v[r][j] = ((const f32x4*)(a.out + (size_t)row * D))[lane + 64 * j];
            if (SS > 1 && ra >= prow0) {
#pragma unroll
                for (int j = 0; j < 4; ++j) ya[r][j] = (f32x4){0.f, 0.f, 0.f, 0.f};
                for (int s = 0; s < SS; ++s) { const f32x4* pp = (const f32x4*)(part + ((size_t)s * pn + (ra - prow0)) * D);
#pragma unroll
                    for (int j = 0; j < 4; ++j) ya[r][j] += pp[lane + 64 * j]; }
#pragma unroll
                for (int j = 0; j < 4; ++j) { const unsigned lo = cvt_pk_bf16(ya[r][j].x, ya[r][j].y), hi2 = cvt_pk_bf16(ya[r][j].z, ya[r][j].w); ya[r][j] = (f32x4){bf_lo(lo), bf_hi(lo), bf_lo(hi2), bf_hi(hi2)}; }
            } else {
#pragma unroll
                for (int j = 0; j < 4; ++j) { const u32x2 y = *((const u32x2*)(Yg + ra * D) + lane + 64 * j); ya[r][j] = (f32x4){bf_lo(y.x), bf_hi(y.x), bf_lo(y.y), bf_hi(y.y)}; } }
            if (SS > 1 && rb >= prow0) {
#pragma unroll
                for (int j = 0; j < 4; ++j) yb[r][j] = (f32x4){0.f, 0.f, 0.f, 0.f};
                for (int s = 0; s < SS; ++s) { const f32x4* pp = (const f32x4*)(part + ((size_t)s * pn + (rb - prow0)) * D);
#pragma unroll
                    for (int j = 0; j < 4; ++j) yb[r][j] += pp[lane + 64 * j]; }
#pragma unroll
                for (int j = 0; j < 4; ++j) { const unsigned lo = cvt_pk_bf16(yb[r][j].x, yb[r][j].y), hi2 = cvt_pk_bf16(yb[r][j].z, yb[r][j].w); yb[r][j] = (f32x4){bf_lo(lo), bf_hi(lo), bf_lo(hi2), bf_hi(hi2)}; }
            } else {
#pragma unroll
                for (int j = 0; j < 4; ++j) { const u32x2 y = *((const u32x2*)(Yg + rb * D) + lane + 64 * j); yb[r][j] = (f32x4){bf_lo(y.x), bf_hi(y.x), bf_lo(y.y), bf_hi(y.y)}; } }
        } }
#pragma unroll
        for (int r = 0; r < 2; ++r) if (ok[r]) { const int row = row0 + r * NGW; const float* g2 = mp1 + (size_t)(row / SEQ) * 6144 + 5 * 1024; float* xr = a.out + (size_t)row * D; float ss = 0.f;
#pragma unroll
            for (int j = 0; j < 4; ++j) { const int c4 = lane + 64 * j; const f32x4 gg = ((const f32x4*)g2)[c4];
                v[r][j] = v[r][j] + gg * (w0[r] * ya[r][j] + w1[r] * yb[r][j]); ss += (v[r][j].x * v[r][j].x + v[r][j].y * v[r][j].y) + (v[r][j].z * v[r][j].z + v[r][j].w * v[r][j].w); }
            const float rs = rsqrtf(wave_sum(ss) * (1.f / D) + EPS);
#pragma unroll
            for (int j = 0; j < 4; ++j) { const int c4 = lane + 64 * j; ((f32x4*)xr)[c4] = v[r][j] * (rs * tscale) * ((const f32x4*)a.in[I_fing])[c4]; } }
    }
}
}
namespace fp {
constexpr int NPH = 20;
#ifndef ALIGN17
#define ALIGN17 true
#endif
constexpr int CW_BAR = 4096;
#ifndef TC_Q2
#define TC_Q2 8
#endif
#ifndef TC_Q5
#define TC_Q5 0
#endif
#ifndef TC_Q8
#define TC_Q8 0
#endif
#ifndef TC_Q10
#define TC_Q10 6
#endif
#ifndef TC_Q11
#define TC_Q11 6
#endif
constexpr int TCA = TC_P0, TCB = TCA + 156 * TC_Q2  , TCC = TCB + 240 * TC_Q5  , TCD = TCC + 240 * TC_Q8  , TCE = TCD + 240 * TC_Q10  , TCF = TCE + 64 * TC_Q11  ;

__global__ void __launch_bounds__(NTHR, 2) fwd(Args args) {
    extern __shared__ __attribute__((aligned(16))) unsigned char lds_raw[];
    Frame F;
    F.lds = (LAS unsigned char*)lds_raw; F.tid = threadIdx.x; F.lane = F.tid & 63; F.wave = __builtin_amdgcn_readfirstlane(F.tid >> 6);
    F.G = gridDim.x; { const int bx = blockIdx.x; F.vcu = (F.G % 8 == 0) ? (bx % 8) * (F.G / 8) + bx / 8 : bx; }
    F.a = &args; F.ws = args.ws; F.tailconv = (gridDim.x == 256 && args.ph_lo == 0 && args.ph_hi == NPH) ? 1 : 0;
    unsigned char* ws = args.ws;
    volatile LAS unsigned* MISC = (volatile LAS unsigned*)(F.lds + LDS_MISC);
    if (F.tid < 64) MISC[F.tid] = 0u;
    { LAS f32x2* rope = (LAS f32x2*)(F.lds + LDS_ROPE); const int pos = F.tid >> 3, f = F.tid & 7; const float inv = powf(10000.f, -(float)f * 0.125f), ang = (float)pos * inv; rope[F.tid] = (f32x2){cosf(ang), sinf(ang)}; }
    __syncthreads();
    const int lo = args.ph_lo, hi = args.ph_hi;
    const bool multi = (hi - lo) > 1;
    XcdBarrier bar; bar.bar = (unsigned*)(ws + WS_CTL) + CW_BAR; bar.x = 0; bar.st = MISC;
    if (multi) bar = xcd_barrier_post((unsigned*)(ws + WS_CTL) + CW_BAR, MISC);
#ifndef PH_MASK
#define PH_MASK 0xFFFFF
#endif
#define IN(k) ((((PH_MASK) >> (k)) & 1) && lo <= (k) && (k) < hi)
#ifndef TSTAMP
#define TSTAMP -1
#endif
    volatile LAS unsigned long long* tsl = (volatile LAS unsigned long long*)(F.lds + LDS_MISC + 128);
#define STAMP(k) do { if (TSTAMP >= 0 && blockIdx.x == 0 && F.tid == 0) { if ((k) == TSTAMP) tsl[0] = wall_clock64(); if ((k) == TSTAMP + TSPAN) tsl[1] = wall_clock64(); } } while (0)
#ifndef TSPAN
#define TSPAN 1
#endif
#ifndef TSDIV
#define TSDIV 4000
#endif
#ifndef PROBE_PH
#define PROBE_PH -1
#endif
#define RPT(k) for (int rep_ = 0; rep_ < ((PROBE_PH == (k)) ? 2 : 1); ++rep_)
#define SEAM(k) do { if (IN(k) && IN((k) + 1)) xcd_barrier(bar); } while (0)
    const LAS f32x2* rope = (const LAS f32x2*)(F.lds + LDS_ROPE);
    float* modp = (float*)(ws + WS_MODP);
    bf16_t* HB = (bf16_t*)(ws + WS_HB);
    float* XC = (float*)(ws + WS_XC);

    F.wait_adaln = (IN(0) && IN(1)) ? 1 : 0;
    STAMP(0);
    if (IN(0)) RPT(0) { p0_prologue(F, rep_); }
    if (IN(0) && IN(1)) { if (!F.tailconv) xcd_barrier(bar); else __syncthreads(); }
    STAMP(1);
    if (IN(1)) RPT(1) { p1_phase(F); } SEAM(1);
    STAMP(2);
    if (IN(2)) { constexpr int REP_ = (PROBE_PH == 2) ? 2 : 1;
        SchedPlain S; S.o.init(MT / 256, NIN / 256, F.G, (int)blockIdx.x, REP_); S.A = HB; S.Bt = (const bf16_t*)(ws + WS_WIN0); S.lda = D; S.ldb = D; S.nt = D / 64;
        EpiInProj E{(bf16_t*)(ws + WS_P), (float*)(ws + WS_SSQ), (bf16_t*)(ws + WS_KF), rope};
        pg8::gemm_phase<EpiInProj, SchedPlain>(F.lds, D, D, D, S, E);
        if (F.tailconv && (int)blockIdx.x >= 100 && REP_ == 1) tail_convert(F, TCA, TCB, (int)blockIdx.x - 100, 156);
    } SEAM(2);
    STAMP(3);
    if (IN(3)) { constexpr int REP_ = (PROBE_PH == 3) ? 2 : 1;
#ifndef NO_QB
        { SchedPlain S; S.o.init(MT / 256, 768 / 256, F.G, (int)blockIdx.x, REP_); S.A = (const bf16_t*)(ws + WS_P); S.Bt = (const bf16_t*)(ws + WS_WQB); S.lda = NIN; S.ldb = 384; S.nt = 384 / 64;
          EpiQb E{(bf16_t*)(ws + WS_Q), (const float*)(ws + WS_SSQ), rope};
          pg8::gemm_phase<EpiQb, SchedPlain>(F.lds, 384, NIN, 384, S, E); }
#endif
#ifndef NO_KVB
        { SchedPlain S; S.o.init(MT / 256, 1024 / 256, F.G, (int)blockIdx.x, REP_); S.A = (const bf16_t*)(ws + WS_P) + 384; S.Bt = (const bf16_t*)(ws + WS_WKVB); S.lda = NIN; S.ldb = 256; S.nt = 256 / 64;
          EpiKvb E{(bf16_t*)(ws + WS_KF), (bf16_t*)(ws + WS_V), (const float*)(ws + WS_SSQ)};
          pg8::gemm_phase<EpiKvb, SchedPlain>(F.lds, 256, NIN, 256, S, E); }
#endif
    } SEAM(3);
    STAMP(4);
    if (IN(4)) RPT(4) { p4_attention(F); } SEAM(4);
    STAMP(5);
    if (IN(5)) { constexpr int REP_ = 1;
        SchedCtxSplit S; S.o.init(64, 4, F.G, (int)blockIdx.x, 1); S.A = (const bf16_t*)(ws + WS_AO); S.Bt = (const bf16_t*)(ws + WS_WOUT); S.lda = D; S.ldb = D; S.ntfull = D / 64; S.S = 4; S.G = F.G; S.c = (int)blockIdx.x;
        EpiBf16OrPart E{(bf16_t*)(ws + WS_Y1), D, (float*)(ws + WS_PART5), ML, MC};
        pg8::gemm_phase<EpiBf16OrPart, SchedCtxSplit>(F.lds, D, D, D, S, E); (void)REP_;
    } SEAM(5);
    STAMP(6);
    if (IN(6)) RPT(6) {
        const int NGW = F.G * NWAVES; const bf16_t* Y1 = (const bf16_t*)(ws + WS_Y1);
        { const int r = F.vcu * NWAVES + F.wave; if (r < MC) { const float* mp = modp + 4 * 6144;
            ctx_row_part(args.in[I_ctx] + (size_t)r * D, XC + (size_t)r * D, (const float*)(ws + WS_PART5), 4, r, mp + 2 * 1024, args.in[I_n2g], mp + 3 * 1024, mp + 4 * 1024, HB + (size_t)(ML + r) * D, F.lane); } }
        { f32x4 gg[4];
#pragma unroll
          for (int j = 0; j < 4; ++j) gg[j] = ((const f32x4*)args.in[I_n2g])[F.lane + 64 * j];
          const int gw = F.vcu * NWAVES + F.wave; RowRegs A0, A1, B0, B1;
#define P6_LOAD(R, k) load_row<true>(R, args.in[I_x] + (size_t)(gw + (k) * NGW) * D, Y1 + (size_t)(gw + (k) * NGW) * D, F.lane)
#define P6_FIN(R, k) do { const int rw_ = gw + (k) * NGW; const float* mp_ = modp + (size_t)(rw_ / SEQ) * 6144; finish_row<true, false>(R, mp_ + 2 * 1024, args.out + (size_t)rw_ * D, gg, mp_ + 3 * 1024, mp_ + 4 * 1024, HB + (size_t)rw_ * D, nullptr, F.lane); } while (0)
          if (gw + 7 * NGW < ML) {
            P6_LOAD(A0, 0); P6_LOAD(A1, 1); P6_LOAD(B0, 2); P6_LOAD(B1, 3);
            P6_FIN(A0, 0); P6_FIN(A1, 1); P6_LOAD(A0, 4); P6_LOAD(A1, 5);
            P6_FIN(B0, 2); P6_FIN(B1, 3); P6_LOAD(B0, 6); P6_LOAD(B1, 7);
            P6_FIN(A0, 4); P6_FIN(A1, 5); P6_FIN(B0, 6); P6_FIN(B1, 7);
          } else { for (int kk = 0; gw + kk * NGW < ML; ++kk) { P6_LOAD(A0, kk); P6_FIN(A0, kk); } }
#undef P6_LOAD
#undef P6_FIN
        }
    } SEAM(6);
    STAMP(7);
    if (IN(7)) { constexpr int REP_ = (PROBE_PH == 7) ? 2 : 1;
        SchedPlain S; S.o.init(MT / 256, 5632 / 256, F.G, (int)blockIdx.x, REP_); S.A = HB; S.Bt = (const bf16_t*)(ws + WS_WFGU); S.lda = D; S.ldb = D; S.nt = D / 64;
        EpiSwiglu E{(bf16_t*)(ws + WS_HF), LDF, 22, (unsigned)((size_t)MT * LDF * 2)};
        pg8::gemm_phase<EpiSwiglu, SchedPlain, ALIGN17>(F.lds, D, D, D, S, E);
    } SEAM(7);
    STAMP(8);
    if (IN(8)) { constexpr int REP_ = 1;
        SchedCtxSplit S; S.o.init(64, 4, F.G, (int)blockIdx.x, 1); S.A = (const bf16_t*)(ws + WS_HF); S.Bt = (const bf16_t*)(ws + WS_WFD); S.lda = LDF; S.ldb = LDF; S.ntfull = DFF / 64; S.S = 11; S.G = F.G; S.c = (int)blockIdx.x;
        EpiBf16OrPart E{(bf16_t*)(ws + WS_Y2), D, (float*)(ws + WS_PART8), ML, MC};
        pg8::gemm_phase<EpiBf16OrPart, SchedCtxSplit>(F.lds, DFF, LDF, LDF, S, E); (void)REP_;
    } SEAM(8);
    STAMP(9);
    if (IN(9)) RPT(9) {
        const int NGW = F.G * NWAVES; const bf16_t* Y2 = (const bf16_t*)(ws + WS_Y2);
        { const int r = F.vcu * NWAVES + F.wave; if (r < MC) { const float* mp0 = modp + 4 * 6144; const float* mp = mp0 + 5 * 6144;
            ctx_row_part(XC + (size_t)r * D, XC + (size_t)r * D, (const float*)(ws + WS_PART8), 11, r, mp0 + 5 * 1024, args.in[I_n1g] + D, mp, mp + 1024, HB + (size_t)(ML + r) * D, F.lane); } }
        { f32x4 gg[4];
#pragma unroll
          for (int j = 0; j < 4; ++j) gg[j] = ((const f32x4*)(args.in[I_n1g] + D))[F.lane + 64 * j];
          const int gw = F.vcu * NWAVES + F.wave; RowRegs A0, A1, B0, B1;
#define P9_LOAD(R, k) load_row<true>(R, args.out + (size_t)(gw + (k) * NGW) * D, Y2 + (size_t)(gw + (k) * NGW) * D, F.lane)
#define P9_FIN(R, k) do { const int rw_ = gw + (k) * NGW; const float* mp0_ = modp + (size_t)(rw_ / SEQ) * 6144; const float* mp_ = mp0_ + 5 * 6144; finish_row<true, false>(R, mp0_ + 5 * 1024, args.out + (size_t)rw_ * D, gg, mp_, mp_ + 1024, HB + (size_t)rw_ * D, nullptr, F.lane); } while (0)
          if (gw + 7 * NGW < ML) {
            P9_LOAD(A0, 0); P9_LOAD(A1, 1); P9_LOAD(B0, 2); P9_LOAD(B1, 3);
            P9_FIN(A0, 0); P9_FIN(A1, 1); P9_LOAD(A0, 4); P9_LOAD(A1, 5);
            P9_FIN(B0, 2); P9_FIN(B1, 3); P9_LOAD(B0, 6); P9_LOAD(B1, 7);
            P9_FIN(A0, 4); P9_FIN(A1, 5); P9_FIN(B0, 6); P9_FIN(B1, 7);
          } else { for (int kk = 0; gw + kk * NGW < ML; ++kk) { P9_LOAD(A0, kk); P9_FIN(A0, kk); } }
#undef P9_LOAD
#undef P9_FIN
        }
    } SEAM(9);
    STAMP(10);
    if (IN(10)) { constexpr int REP_ = (PROBE_PH == 10) ? 2 : 1;
        SchedPlain S; S.o.init(MT / 256, D / 256, F.G, (int)blockIdx.x, REP_); S.A = HB; S.Bt = (const bf16_t*)(ws + WS_WS5); S.lda = D; S.ldb = D; S.nt = D / 64;
        EpiS5In E{(bf16_t*)(ws + WS_ACAT), (bf16_t*)(ws + WS_ACATC)};
        pg8::gemm_phase<EpiS5In, SchedPlain>(F.lds, D, D, D, S, E);
        if (F.tailconv && (int)blockIdx.x >= 16 && REP_ == 1) tail_convert(F, TCD, TCE, (int)blockIdx.x - 16, 240);
    } SEAM(10);
    STAMP(11);
    if (IN(11)) { constexpr int REP_ = (PROBE_PH == 11) ? 2 : 1;
        SchedSloc S; S.o.init(64 * 3, 1, F.G, (int)blockIdx.x, REP_); S.acat = (const bf16_t*)(ws + WS_ACAT); S.acatc = (const bf16_t*)(ws + WS_ACATC); S.bhat = (const bf16_t*)(ws + WS_BHAT);
        EpiSloc E{(float*)(ws + WS_SLOC)};
        pg8::gemm_phase<EpiSloc, SchedSloc>(F.lds, SK, SKA, SK, S, E);
#ifndef LT_IN_P11
#define LT_IN_P11 0
#endif
        if (F.tailconv && (int)blockIdx.x >= 192 && REP_ == 1) { if (LT_IN_P11) lt_expand(F, ((int)blockIdx.x - 192) * NWAVES + F.wave, 64 * NWAVES); tail_convert(F, TCE, TCF, (int)blockIdx.x - 192, 64); }
    } SEAM(11);
    STAMP(12);
    if (IN(12)) RPT(12) { p12_scan(F); if (F.tailconv && F.vcu >= 64 && rep_ == 0) { if (!LT_IN_P1 && !LT_IN_P11) lt_expand(F, (F.vcu - 64) * NWAVES + F.wave, 192 * NWAVES); tail_convert(F, TCF, TC_CHUNKS, F.vcu - 64, 192); } } SEAM(12);
    STAMP(13);
    if (IN(13)) { constexpr int REP_ = (PROBE_PH == 13) ? 2 : 1;
        SchedS5Out S; S.o.init(64 * 2, 2, F.G, (int)blockIdx.x, REP_); S.acat = (const bf16_t*)(ws + WS_ACAT); S.lt = (const bf16_t*)(ws + WS_LT);
        EpiS5Out E{(const bf16_t*)(ws + WS_ACAT), args.in[I_odd], (bf16_t*)(ws + WS_GB)};
        pg8::gemm_phase<EpiS5Out, SchedS5Out>(F.lds, SKA, SKA, SKA, S, E);
    } SEAM(13);
    STAMP(14);
    if (IN(14)) { constexpr int REP_ = (PROBE_PH == 14) ? 2 : 1;
        SchedPlain S; S.o.init(ML / 256, 2048 / 256, F.G, (int)blockIdx.x, REP_); S.A = (const bf16_t*)(ws + WS_GB); S.Bt = (const bf16_t*)(ws + WS_WGLU); S.lda = D; S.ldb = D; S.nt = D / 64;
        EpiGlu E{(bf16_t*)(ws + WS_Y3)};
        pg8::gemm_phase<EpiGlu, SchedPlain>(F.lds, D, D, D, S, E);
    } SEAM(14);
    STAMP(15);
    if (IN(15)) RPT(15) { p15_route_gather(F); FSTAMP(F, 102); }
    if (IN(15) && IN(17)) xcd_barrier(bar);
    STAMP(17);
    if (IN(17)) { constexpr int REP_ = (PROBE_PH == 17) ? 2 : 1;
        if (!IN(15)) moe_tables(F);
        const LAS int* toff = (const LAS int*)(F.lds + LDS_MOE);
        SchedMoe S; S.o.init(toff[NE], 28, F.G, (int)blockIdx.x, REP_); S.A = (const bf16_t*)(ws + WS_XG); S.W = (const bf16_t*)(ws + WS_WMOE_GU); S.lda = D; S.ldb = D; S.nrows_e = 7168; S.tile_e = toff + 16; S.nt = D / 64;
        EpiSwiglu E{(bf16_t*)(ws + WS_HM), DFE, 28, (unsigned)((size_t)MOE_ROWS * DFE * 2)};
#ifndef STAG17
#define STAG17 0
#endif
        if (STAG17) { const int units = toff[NE] * 28, rem = units % F.G;
            if (rem > 0 && (int)blockIdx.x >= rem) { const int k = ((int)blockIdx.x & 3) + 1; for (int i = 0; i < k * STAG17; ++i) __builtin_amdgcn_s_sleep(127); } }
        pg8::gemm_phase<EpiSwiglu, SchedMoe, ALIGN17>(F.lds, D, D, D, S, E);
    } SEAM(17);
    STAMP(18);
    if (IN(18)) { constexpr int REP_ = (PROBE_PH == 18) ? 2 : 1;
        if (!IN(17)) moe_tables(F);
        const LAS int* toff = (const LAS int*)(F.lds + LDS_MOE);
        const int NT = toff[NE]; int RT, SS; moe_split_plan(NT, F.G, RT, SS);
        SchedMoeD S; S.o.init(RT, 4, F.G, (int)blockIdx.x, 1); S.A = (const bf16_t*)(ws + WS_HM); S.W = (const bf16_t*)(ws + WS_WMOE_D); S.lda = DFE; S.ldb = DFE; S.ntfull = DFE / 64; S.S = SS; S.G = F.G; S.c = (int)blockIdx.x; S.RT = RT; S.NT = NT; S.tile_e = toff + 16;
        EpiBf16OrPart E{(bf16_t*)(ws + WS_XG), D, (float*)(ws + WS_PART18), RT * 256, (NT - RT) * 256};
        pg8::gemm_phase<EpiBf16OrPart, SchedMoeD>(F.lds, DFE, DFE, DFE, S, E); (void)REP_;
    }
    if (TSTAMP >= 0 && blockIdx.x == 0 && F.tid == 0) { if (TSTAMP + TSPAN >= 19) tsl[1] = wall_clock64(); const float us = (float)(tsl[1] - tsl[0]) * 0.01f; ((float*)(ws + WS_CTL + CTL_TS))[0] = 1.f + us * (1.f / (float)TSDIV); }
    SEAM(18);
    STAMP(19);
    if (IN(19)) RPT(19) { if (!IN(18)) moe_tables(F); p19_final(F); }
#undef IN
#undef SEAM
}

inline void launch_range(const Args& base, int lo, int hi, int grid, hipStream_t stream, bool zero_bar) {
    Args a = base; a.ph_lo = lo; a.ph_hi = hi;
    if (zero_bar && hi - lo > 1) (void)hipMemsetAsync(a.ws + WS_CTL + (size_t)CW_BAR * 4, 0, XCD_BAR_WORDS * 4, stream);
    hipLaunchKernelGGL(fwd, dim3(grid), dim3(NTHR), LDS_BYTES, stream, a);
    const hipError_t le = hipPeekAtLastError();
    if (le != hipSuccess) fprintf(stderr, "kernel_launch: launch [%d,%d) failed: %s\n", lo, hi, hipGetErrorName(le));
}
}

#ifndef DBG_MODE
#define DBG_MODE 0
#endif
#ifndef PER_PHASE
#define PER_PHASE 0
#endif
extern "C" void kernel_launch(void* const* d_in, const int* in_sizes, int n_in, void* d_out, int out_size, void* d_ws, size_t ws_size, hipStream_t stream) {
    (void)in_sizes; (void)out_size;
    static int grid = 0;
    if (grid == 0) {
        int dev = 0, cus = 0;
        if (n_in != 33 || ws_size < fp::WS_END || hipGetDevice(&dev) != hipSuccess || hipDeviceGetAttribute(&cus, hipDeviceAttributeMultiprocessorCount, dev) != hipSuccess) { fprintf(stderr, "kernel_launch: bad setup (n_in %d ws %zu)\n", n_in, ws_size); grid = -1; return; }
        if (hipFuncSetAttribute((const void*)fp::fwd, hipFuncAttributeMaxDynamicSharedMemorySize, fp::LDS_BYTES) != hipSuccess) { fprintf(stderr, "kernel_launch: hipFuncSetAttribute failed\n"); grid = -1; return; }
        int per_cu = 0; (void)hipOccupancyMaxActiveBlocksPerMultiprocessor(&per_cu, (const void*)fp::fwd, fp::NTHR, fp::LDS_BYTES); (void)hipGetLastError();
        if (per_cu < 1) fprintf(stderr, "kernel_launch: occupancy query says %d\n", per_cu);
        grid = cus;
    }
    if (grid < 0) return;
    fp::Args a{};
    for (int i = 0; i < 33; ++i) a.in[i] = (const float*)d_in[i];
    a.out = (float*)d_out; a.ws = (unsigned char*)d_ws; a.ph_lo = 0; a.ph_hi = fp::NPH;
    auto run = [&](int lo, int hi) {
#if PER_PHASE
        for (int k = lo; k < hi; ++k) fp::launch_range(a, k, k + 1, grid, stream, false);
#else
        fp::launch_range(a, lo, hi, grid, stream, DBG_MODE != 0);
#endif
    };
    (void)hipMemsetAsync((char*)d_ws + fp::WS_CTL, 0, fp::CTL_BYTES, stream);
    run(0, fp::NPH);
}
```

```cpp
#define DBG_MODE 0
#define PER_PHASE 0
#include <hip/hip_runtime.h>
#include <cstdio>
#include <cstdint>
#define LAS __attribute__((address_space(3)))
#define GAS __attribute__((address_space(1)))
typedef unsigned short bf16_t;
typedef short bf16x8 __attribute__((ext_vector_type(8)));
typedef short s16x4 __attribute__((ext_vector_type(4)));
typedef float f32x4 __attribute__((ext_vector_type(4)));
typedef float f32x16 __attribute__((ext_vector_type(16)));
typedef unsigned u32x4 __attribute__((ext_vector_type(4)));
typedef unsigned u32x2 __attribute__((ext_vector_type(2)));
typedef float f32x2 __attribute__((ext_vector_type(2)));

__device__ __forceinline__ unsigned f2bf(float f) { unsigned u = __builtin_bit_cast(unsigned, f); return (u + 0x7fffu + ((u >> 16) & 1u)) >> 16; }
__device__ __forceinline__ unsigned pk2(float lo, float hi) { return f2bf(lo) | (f2bf(hi) << 16); }
__device__ __forceinline__ unsigned cvt_pk_bf16(float lo, float hi) { unsigned r; asm volatile("v_cvt_pk_bf16_f32 %0, %1, %2" : "=v"(r) : "v"(lo), "v"(hi)); return r; }
__device__ __forceinline__ float bf_lo(unsigned w) { return __builtin_bit_cast(float, w << 16); }
__device__ __forceinline__ float bf_hi(unsigned w) { return __builtin_bit_cast(float, w & 0xffff0000u); }
__device__ __forceinline__ float wave_sum(float v) {
#pragma unroll
    for (int o = 1; o < 64; o <<= 1) v += __shfl_xor(v, o);
    return v;
}
__device__ __forceinline__ float fast_sigmoid(float x) { return __builtin_amdgcn_rcpf(1.f + __builtin_amdgcn_exp2f(-1.4426950408889634f * x)); }

namespace pg8 {
constexpr int BM = 256, BK = 64, HALF = 128, HTB = HALF * BK * 2  , STAGE_BYTES = 8 * HTB, NXCD = 8, WGM = 8;
__host__ __device__ __forceinline__ int lds_byte(int r, int c) { const int st = (r >> 4) * 2 + (c >> 5), rr = r & 15, cc = c & 31, ob = rr * 64 + cc * 2; return st * 1024 + (ob ^ (((ob >> 9) & 1) << 5)); }
__host__ __device__ __forceinline__ void stage_rc(int b, int& R, int& C) { const int st = b / 1024, sb = b % 1024, swz = sb ^ (((sb >> 9) & 1) << 5); R = (st >> 1) * 16 + swz / 64; C = (st & 1) * 32 + (swz % 64) / 2; }
__host__ __device__ __forceinline__ int perm32(int rho) { const int n = rho >> 4, i = rho & 15; return 8 * (i >> 2) + 4 * n + (i & 3); }

struct Unit { int pm, pn, ks; };
struct Order {
    int nM, nN, nwg, G, c, rep;
    __device__ __forceinline__ void init(int nM_, int nN_, int G_, int c_, int rep_ = 1) { nM = nM_; nN = nN_; nwg = nM * nN; G = G_; c = c_; rep = rep_; }
    __device__ __forceinline__ bool next(int i, Unit& u) const {
        long L = (long)i * G + c; if (L >= (long)nwg * rep) return false; L %= nwg; map((int)L, u); return true; }
    __device__ __forceinline__ void map(int L, Unit& u) const {
        int wgid = L; u.ks = -1; { const int q = nwg / NXCD, r = nwg % NXCD, xcd = wgid % NXCD, off = wgid / NXCD; wgid = (xcd < r ? xcd * (q + 1) : r * (q + 1) + (xcd - r) * q) + off; }
        const int nig = WGM * nN, gid = wgid / nig, fm = gid * WGM, gsz = (nM - fm) < WGM ? (nM - fm) : WGM;
        u.pm = fm + ((wgid % nig) % gsz); u.pn = (wgid % nig) / gsz;
    }
};

template <class Epi, class Sched, bool ALIGN_EPI = true>
__device__ __forceinline__ void gemm_phase(LAS unsigned char* lds, const int K, const int lda, const int ldb, const Sched& S, const Epi& E) {
    const int tid = threadIdx.x, wid = __builtin_amdgcn_readfirstlane(tid >> 6), lane = tid & 63, wr = wid >> 2, wc = wid & 3, fr = lane & 15, fq = lane >> 4;
    unsigned voffA[2], voffB[2];
#pragma unroll
    for (int i = 0; i < 2; ++i) { int R, C; stage_rc(tid * 16 + i * 8192, R, C); const int Rb = (R & ~31) + perm32(R & 31);
        voffA[i] = (unsigned)(R * lda + C) * 2u; voffB[i] = (unsigned)(Rb * ldb + C) * 2u; }
    const size_t kstep = (size_t)(BK * 2);
    const size_t hstepA = (size_t)HALF * lda * 2, hstepB = (size_t)HALF * ldb * 2;
    const unsigned ldsw = (unsigned)wid * 1024u;
    const int aoff = lds_byte(wr * 64 + fr, fq * 8), boff = lds_byte(wc * 32 + fr, fq * 8);
#define PG8_SA(b, h) (((b) * 2 + (h)) * HTB)
#define PG8_SB(b, h) ((4 + (b) * 2 + (h)) * HTB)
#define PG8_STAGE(bufoff, gbase, voff) do { _Pragma("unroll") for (int _i = 0; _i < 2; ++_i) \
        __builtin_amdgcn_global_load_lds((const unsigned*)((const char*)(gbase) + (voff)[_i]), (LAS unsigned*)(lds + (bufoff) + ldsw + _i * 8192), 16, 0, 0); } while (0)
#define PG8_LDA(dst, b, h) do { _Pragma("unroll") for (int m = 0; m < 4; ++m) _Pragma("unroll") for (int k = 0; k < 2; ++k) dst[m][k] = *(const LAS bf16x8*)(lds + PG8_SA(b, h) + aoff + m * 2048 + k * 1024); } while (0)
#define PG8_LDB(dst, b, h) do { _Pragma("unroll") for (int n = 0; n < 2; ++n) _Pragma("unroll") for (int k = 0; k < 2; ++k) dst[n][k] = *(const LAS bf16x8*)(lds + PG8_SB(b, h) + boff + n * 2048 + k * 1024); } while (0)
#define PG8_MMA(ai, bj, At, Bt) do { __builtin_amdgcn_s_setprio(1); _Pragma("unroll") for (int m = 0; m < 4; ++m) _Pragma("unroll") for (int n = 0; n < 2; ++n) _Pragma("unroll") for (int k = 0; k < 2; ++k) \
        acc[ai][bj][m][n] = __builtin_amdgcn_mfma_f32_16x16x32_bf16(Bt[n][k], At[m][k], acc[ai][bj][m][n], 0, 0, 0); __builtin_amdgcn_s_setprio(0); } while (0)
#define PG8_WAIT_V(n) asm volatile("s_waitcnt vmcnt(" #n ")" ::: "memory")
#define PG8_WAIT_L(n) asm volatile("s_waitcnt lgkmcnt(" #n ")" ::: "memory")
#define PG8_BAR __builtin_amdgcn_s_barrier()
#define PG8_SCHED __builtin_amdgcn_sched_barrier(0)
    Unit cur, nxt; int ui = 0;
    if (!S.next(0, cur)) return;
    f32x4 acc[2][2][4][2];
#pragma unroll
    for (int a = 0; a < 2; ++a)
#pragma unroll
        for (int b = 0; b < 2; ++b)
#pragma unroll
            for (int m = 0; m < 4; ++m)
#pragma unroll
                for (int n = 0; n < 2; ++n) acc[a][b][m][n] = (f32x4){0.f, 0.f, 0.f, 0.f};
    bf16x8 At[4][2], B0[2][2], B1[2][2];
    const char* cA = S.aptr(cur); const char* cB = S.bptr(cur); int nt = S.ktiles(cur); (void)K;
    PG8_STAGE(PG8_SB(0, 0), cB, voffB); PG8_STAGE(PG8_SB(0, 1), cB + hstepB, voffB); PG8_STAGE(PG8_SA(0, 0), cA, voffA); PG8_STAGE(PG8_SA(0, 1), cA + hstepA, voffA);
    if (wr == 1) PG8_BAR;
    PG8_WAIT_V(2); PG8_BAR;
    PG8_STAGE(PG8_SB(1, 0), cB + kstep, voffB); PG8_STAGE(PG8_SA(1, 0), cA + kstep, voffA); PG8_STAGE(PG8_SB(1, 1), cB + hstepB + kstep, voffB);
    PG8_WAIT_V(6); PG8_BAR;
    for (;;) {
        const bool has_next = S.next(ui + 1, nxt);
        const char* nA = has_next ? S.aptr(nxt) : cA; const char* nB = has_next ? S.bptr(nxt) : cB;
#pragma unroll 1
        for (int t = 0; t < nt; t += 2) {
            const bool last = (t == nt - 2);
            const char* a1 = cA + (size_t)(t + 1) * kstep;
            const char* a2 = last ? nA : cA + (size_t)(t + 2) * kstep; const char* b2 = last ? nB : cB + (size_t)(t + 2) * kstep;
            const char* a3 = a2 + kstep; const char* b3 = b2 + kstep;
            PG8_LDB(B0, 0, 0); PG8_LDB(B1, 0, 1); PG8_SCHED; PG8_LDA(At, 0, 0); PG8_STAGE(PG8_SA(1, 1), a1 + hstepA, voffA);
            PG8_WAIT_V(8); PG8_WAIT_L(0); PG8_BAR; PG8_MMA(0, 0, At, B0); PG8_MMA(0, 1, At, B1); PG8_BAR; PG8_SCHED;
            PG8_LDA(At, 0, 1); PG8_STAGE(PG8_SB(0, 0), b2, voffB); PG8_STAGE(PG8_SB(0, 1), b2 + hstepB, voffB); PG8_STAGE(PG8_SA(0, 0), a2, voffA);
            PG8_WAIT_V(8); PG8_WAIT_L(0); PG8_BAR; PG8_MMA(1, 0, At, B0); PG8_MMA(1, 1, At, B1); PG8_BAR; PG8_SCHED;
            PG8_LDB(B0, 1, 0); PG8_LDB(B1, 1, 1); PG8_SCHED; PG8_LDA(At, 1, 0); PG8_STAGE(PG8_SA(0, 1), a2 + hstepA, voffA);
            PG8_WAIT_V(8); PG8_WAIT_L(0); PG8_BAR; PG8_MMA(0, 0, At, B0); PG8_MMA(0, 1, At, B1); PG8_BAR; PG8_SCHED;
            PG8_LDA(At, 1, 1); PG8_STAGE(PG8_SB(1, 0), b3, voffB); PG8_STAGE(PG8_SB(1, 1), b3 + hstepB, voffB); PG8_STAGE(PG8_SA(1, 0), a3, voffA);
            PG8_WAIT_V(8); PG8_WAIT_L(0); PG8_BAR; PG8_MMA(1, 0, At, B0); PG8_MMA(1, 1, At, B1); PG8_BAR; PG8_SCHED;
        }
        if constexpr (ALIGN_EPI) { if (wr == 0) PG8_BAR; }
        E(acc, cur, wr, wc, fr, fq);
        if (!has_next) break;
#pragma unroll
        for (int a = 0; a < 2; ++a)
#pragma unroll
            for (int b = 0; b < 2; ++b)
#pragma unroll
                for (int m = 0; m < 4; ++m)
#pragma unroll
                    for (int n = 0; n < 2; ++n) acc[a][b][m][n] = (f32x4){0.f, 0.f, 0.f, 0.f};
        cur = nxt; cA = nA; cB = nB; ++ui; nt = S.ktiles(cur);
        if constexpr (ALIGN_EPI) { if (wr == 1) PG8_BAR; }
    }
    PG8_WAIT_V(0);
    if constexpr (!ALIGN_EPI) { if (wr == 0) PG8_BAR; }
    PG8_BAR;
#undef PG8_SA
#undef PG8_SB
#undef PG8_STAGE
#undef PG8_LDA
#undef PG8_LDB
#undef PG8_MMA
#undef PG8_WAIT_V
#undef PG8_WAIT_L
#undef PG8_BAR
#undef PG8_SCHED
}
}

#define XB_TMO      128
#define XB_XCNT(j)  (256  + 64 * (j))
#define XB_XSUB(j)  (1280 + 64 * (j))
#define XB_XGEN(j)  (2304 + 64 * (j))
#define XB_TOP      3328
#define XB_TOPGEN   3392
#define XCD_BAR_WORDS 3456
#define XB_SPIN_CAP (1u << 18)
__device__ __forceinline__ unsigned xb_ld(unsigned* p)              { return __hip_atomic_load(p, __ATOMIC_RELAXED, __HIP_MEMORY_SCOPE_AGENT); }
__device__ __forceinline__ unsigned xb_add(unsigned* p, unsigned v) { return __hip_atomic_fetch_add(p, v, __ATOMIC_RELAXED, __HIP_MEMORY_SCOPE_AGENT); }
__device__ __forceinline__ unsigned xb_xcc_id() { return (unsigned)__builtin_amdgcn_s_getreg((3 << 11) | 20) & 0xFu; }
#define XB_SPIN(cond, bar) do { unsigned _sp = 0; while (cond) { __builtin_amdgcn_s_sleep(1); \
    if ((++_sp & 255u) == 0u) { if (xb_ld(&(bar)[XB_TMO])) break; if (_sp > XB_SPIN_CAP) { atomicAdd(&(bar)[XB_TMO], 1u); break; } } } } while (0)
struct XcdBarrier { unsigned* bar; unsigned x; volatile LAS unsigned* st; };
__device__ __forceinline__ XcdBarrier xcd_barrier_post(unsigned* bar, volatile LAS unsigned* st) {
    XcdBarrier b; b.bar = bar; b.x = xb_xcc_id(); b.st = st;
    if (threadIdx.x == 0) (void)xb_add(&bar[XB_XCNT(b.x)], 1u);
    return b;
}
__device__ __forceinline__ void xcd_barrier_complete(unsigned* bar, unsigned x, unsigned& nloc, unsigned& nx) {
    const unsigned G = gridDim.x * gridDim.y * gridDim.z;
    unsigned sum, cnt, mine, sp = 0u;
    for (;;) {
        sum = 0u; cnt = 0u; mine = 0u;
#pragma unroll
        for (unsigned j = 0; j < 16; ++j) { const unsigned c = xb_ld(&bar[XB_XCNT(j)]); sum += c; cnt += (c > 0u) ? 1u : 0u; mine = (j == x) ? c : mine; }
        if (sum == G) break;
        __builtin_amdgcn_s_sleep(1);
        if ((++sp & 255u) == 0u) { if (xb_ld(&bar[XB_TMO])) break; if (sp > XB_SPIN_CAP) { atomicAdd(&bar[XB_TMO], 1u); break; } }
    }
    nloc = mine > 0u ? mine : 1u; nx = cnt > 0u ? cnt : 1u;
}
__device__ __forceinline__ void xcd_barrier(const XcdBarrier& b) {
    asm volatile("s_waitcnt vmcnt(0)" ::: "memory");
    __syncthreads();
    if (threadIdx.x == 0) {
        unsigned* bar = b.bar;
        __builtin_amdgcn_s_waitcnt(0);
        unsigned nloc = b.st[0], nx = b.st[1];
        if (nloc == 0u) { xcd_barrier_complete(bar, b.x, nloc, nx); b.st[0] = nloc; b.st[1] = nx; }
        const unsigned old = xb_add(&bar[XB_XSUB(b.x)], 1u);
        const unsigned gen = old / nloc;
        if (old + 1u == (gen + 1u) * nloc) {
            __builtin_amdgcn_fence(__ATOMIC_RELEASE, "agent");
            asm volatile("s_waitcnt vmcnt(0)" ::: "memory");
            const unsigned og = xb_add(&bar[XB_TOP], 1u);
            const unsigned tg = og / nx;
            if (og + 1u == (tg + 1u) * nx) xb_add(&bar[XB_TOPGEN], 1u);
            else XB_SPIN(xb_ld(&bar[XB_TOPGEN]) == tg, bar);
            __builtin_amdgcn_fence(__ATOMIC_ACQUIRE, "agent");
            xb_add(&bar[XB_XGEN(b.x)], 1u);
            asm volatile("s_waitcnt vmcnt(0)" ::: "memory");
        } else {
            XB_SPIN(xb_ld(&bar[XB_XGEN(b.x)]) == gen, bar);
            __builtin_amdgcn_fence(__ATOMIC_ACQUIRE, "agent");
            asm volatile("s_waitcnt vmcnt(0)" ::: "memory");
        }
    }
    __syncthreads();
}
namespace fp {
constexpr int D = 1024, NB = 4, SEQ = 4096, CTX = 256, ML = NB * SEQ, MC = NB * CTX, MT = ML + MC;
constexpr int NIN = 2304;
constexpr int DFF = 2816, DFE = 3584, NE = 8;
#ifndef DFFP
#define DFFP 2816
#endif
constexpr int LDF = DFFP;
constexpr int NWAVES = 8, NTHR = 512;
constexpr float LOG2E = 1.4426950408889634f;
constexpr float C2_MLA = 0.10206207261596577f * LOG2E;
constexpr float C2_NA = 0.125f * LOG2E;
constexpr float EPS = 1e-6f;
constexpr int TCH = 32, NCH = SEQ / TCH  , NCHC = CTX / TCH  , SK = TCH * 16  , SKA = SK + 256  ;

constexpr size_t MiB = 1u << 20;
constexpr size_t WS_CTL = 0, CTL_BYTES = 1 * MiB;
constexpr size_t WS_SSQ = 10 * MiB;
constexpr size_t CTL_CNT = 256 * 1024;
constexpr size_t CTL_DONE = 280 * 1024;
constexpr size_t CTL_ADALN = 290 * 1024;
constexpr size_t CTL_BTAB = 320 * 1024;
constexpr size_t CTL_TS = 310 * 1024;
constexpr size_t CTL_Q0 = 300 * 1024;
constexpr size_t WS_MODP = 1 * MiB;
constexpr size_t WS_TOK = WS_MODP + 256 * 1024;
constexpr size_t WS_XC = 2 * MiB;
constexpr size_t WS_KKER = 6 * MiB;
constexpr size_t WS_WMOE_GU = 12 * MiB;
constexpr size_t WS_WMOE_D = WS_WMOE_GU + 112 * MiB;
constexpr size_t WS_C = 180 * MiB;
constexpr size_t WS_WIN0 = WS_C;
constexpr size_t WS_WQB = WS_WIN0 + (size_t)NIN * D * 2;
constexpr size_t WS_WKVB = WS_WQB + 768 * 384 * 2;
constexpr size_t WS_WOUT = WS_WKVB + 1024 * 256 * 2;
constexpr size_t WS_WFGU = WS_WOUT + 1024 * 1024 * 2;
constexpr size_t WS_WFD = WS_WFGU + (size_t)5632 * 1024 * 2;
constexpr size_t WS_WS5 = WS_WFD + (size_t)1024 * LDF * 2;
constexpr size_t WS_WGLU = WS_WS5 + 1024 * 1024 * 2;
constexpr size_t WS_BHAT = WS_WGLU + 2048 * 1024 * 2;
constexpr size_t WS_LT = WS_BHAT + (size_t)64 * 256 * SK * 2;
constexpr size_t WS_WEND = WS_LT + (size_t)64 * 512 * SKA * 2;
static_assert(WS_WEND <= 275 * MiB, "non-moe weights region");
constexpr size_t WS_ACT = 275 * MiB;
constexpr size_t WS_HB = 479 * MiB;
constexpr size_t WS_END = WS_HB + (size_t)MT * D * 2;
static_assert(WS_END <= 513 * MiB, "ws end");
constexpr size_t WS_P = WS_ACT;
constexpr size_t WS_Q = WS_P + (size_t)MT * NIN * 2;
constexpr size_t WS_KF = WS_Q + (size_t)MT * 768 * 2;
constexpr size_t WS_V = WS_KF + (size_t)MT * 768 * 2;
constexpr size_t WS_AO = WS_V + (size_t)MT * 512 * 2;
static_assert(WS_AO + (size_t)MT * D * 2 <= WS_HB, "L0 mixer activations");
constexpr size_t WS_HF = WS_ACT;
static_assert(WS_HF + (size_t)MT * LDF * 2 <= WS_AO, "HF must not overlay AO (w_out reads AO before HF is written? no: separate phases, but keep clear)");
constexpr size_t WS_ACAT = WS_ACT;
constexpr size_t WS_ACATC = WS_ACAT + (size_t)64 * 512 * SKA * 2;
constexpr size_t WS_SLOC = WS_ACATC + (size_t)(64 * 32 + 256) * SKA * 2;
constexpr size_t WS_GB = WS_SLOC + (size_t)64 * 544 * 256 * 4;
static_assert(WS_GB + (size_t)ML * D * 2 <= WS_HB, "L1 mixer activations");
constexpr size_t WS_Y1 = WS_ACT;
constexpr size_t WS_Y2 = 413 * MiB;
constexpr size_t WS_XB = 447 * MiB;
static_assert(WS_Y2 + (size_t)MT * D * 2 <= WS_XB && WS_XB + (size_t)ML * D * 2 <= WS_HB, "Y2 / XB placement");
constexpr size_t WS_Y3 = 400 * MiB;
static_assert(WS_GB + (size_t)ML * D * 2 <= WS_Y3 && WS_Y3 + (size_t)ML * D * 2 <= WS_XB, "Y3 placement");
constexpr size_t WS_PART5 = 320 * MiB;
constexpr size_t WS_PART8 = 369 * MiB;
static_assert(WS_PART8 + (size_t)11 * MC * D * 4 <= WS_Y2 && WS_HF + (size_t)MT * LDF * 2 <= WS_PART8, "PART8 placement");
constexpr size_t WS_PART18 = WS_WMOE_GU;
constexpr int MOE_ROWS = 2 * ML + NE * 256;
constexpr size_t WS_XG = WS_C;
constexpr size_t WS_HM = WS_XG + (size_t)MOE_ROWS * D * 2;
static_assert(WS_HM + (size_t)MOE_ROWS * DFE * 2 <= 513 * MiB, "moe hidden");

constexpr int RING_BYTES = 131072;
constexpr int LDS_ROPE = RING_BYTES;
constexpr int LDS_MISC = LDS_ROPE + 4096;
constexpr int LDS_MOE = LDS_MISC + 256;
constexpr int LDS_BIAS = LDS_MOE + 1024;
constexpr int LDS_MODT = LDS_BIAS + 2048;
constexpr int LDS_BYTES = 151552;
static_assert(LDS_MODT + 12288 <= LDS_BYTES && LDS_BYTES <= 163840, "lds map");

struct Args {
    const float* in[33];
    float* out; unsigned char* ws;
    int ph_lo, ph_hi;
};
enum { I_x = 0, I_c, I_ctx, I_cctx, I_modw, I_modb, I_n1g, I_n2g, I_win, I_qng, I_wqb, I_kvng, I_wkvb, I_rpb, I_wout, I_fg, I_fu, I_fd, I_s5in, I_are, I_aim, I_lstep, I_bre, I_bim, I_cre, I_cim, I_odd, I_wglu,
       I_router, I_mg, I_mu, I_md, I_fing };

struct Frame {
    LAS unsigned char* lds;
    int tid, lane, wave, vcu, G, tailconv, wait_adaln;
    const Args* a;
    unsigned char* ws;
};
__device__ __forceinline__ int cond_of_tile(int pm) { return pm < 64 ? (pm >> 4) : NB; }
__device__ __forceinline__ int cond_of_row(int row) { return row < ML ? row / SEQ : NB; }

struct ConvSrc { const float* src; int ld; int col0; int perm; float scale; const float* gain; };
__device__ __forceinline__ int rope_src_dim(int c) { return (c & 16) + ((c & 1) ? 8 : 0) + ((c & 15) >> 1); }
struct ConvItem { ConvSrc cs; bf16_t* dst; int ldd, n0, k0; };
__device__ __forceinline__ void conv_load(const ConvItem& ci, f32x4 (&v)[8], int lane) {
    if (ci.cs.col0 >= 0) {
        const int c4 = 4 * (lane & 7), r8 = lane >> 3;
        const float* sp = ci.cs.src + (size_t)(ci.k0 + r8) * ci.cs.ld + ci.cs.col0 + c4;
#pragma unroll
        for (int i = 0; i < 8; ++i) v[i] = *(const f32x4*)(sp + (size_t)(8 * i) * ci.cs.ld);
    }
}
__device__ __forceinline__ void conv_finish(const ConvItem& ci, const f32x4 (&v)[8], LAS float* scr, int lane) {
    const ConvSrc& cs = ci.cs;
    if (cs.col0 >= 0) {
        const int c4 = 4 * (lane & 7), r8 = lane >> 3;
#pragma unroll
        for (int i = 0; i < 8; ++i) { const int kk = r8 + 8 * i; float g = cs.scale; if (cs.gain) g *= cs.gain[ci.k0 + kk];
            scr[kk * 33 + c4] = v[i].x * g; scr[kk * 33 + c4 + 1] = v[i].y * g; scr[kk * 33 + c4 + 2] = v[i].z * g; scr[kk * 33 + c4 + 3] = v[i].w * g; }
    }
    asm volatile("s_waitcnt lgkmcnt(0)" ::: "memory");
    const int c = lane & 7;
#pragma unroll
    for (int j = 0; j < 4; ++j) { const int n = (lane >> 3) + 8 * j; const int ns = cs.perm ? rope_src_dim(n) : n; const LAS float* s = scr + (8 * c) * 33 + ns;
        u32x4 o;
        if (cs.col0 >= 0) { o.x = cvt_pk_bf16(s[0 * 33], s[1 * 33]); o.y = cvt_pk_bf16(s[2 * 33], s[3 * 33]); o.z = cvt_pk_bf16(s[4 * 33], s[5 * 33]); o.w = cvt_pk_bf16(s[6 * 33], s[7 * 33]); }
        else o = (u32x4){0u, 0u, 0u, 0u};
        *(u32x4*)(ci.dst + (size_t)(ci.n0 + n) * ci.ldd + ci.k0 + 8 * c) = o; }
    asm volatile("s_waitcnt lgkmcnt(0)" ::: "memory");
}
__device__ __forceinline__ ConvSrc gu_src(const float* ga, const float* gb, int ld, int n0) { const int tile = n0 >> 8, w = n0 & 255; ConvSrc c; c.src = w < 128 ? ga : gb; c.ld = ld; c.col0 = tile * 128 + (w & 127); c.perm = 0; c.scale = 1.f; c.gain = nullptr; return c; }

__device__ __forceinline__ f32x4 s5_disc(const Args& a, int g, int dir, int p) {
    const float dt = expf(a.in[I_lstep][dir * 64 + g]); const float ar = a.in[I_are][(dir * 64 + g) * 64 + p], ai = a.in[I_aim][(dir * 64 + g) * 64 + p];
    const float decay = expf(ar * dt), abr = decay * cosf(ai * dt), abi = decay * sinf(ai * dt), den = ar * ar + ai * ai;
    const float fr = ((abr - 1.f) * ar + abi * ai) / den, fi = (abi * ar - (abr - 1.f) * ai) / den;
    return (f32x4){ar * dt, ai * dt, fr, fi};
}
__device__ __forceinline__ f32x2 s5_adt(const Args& a, int g, int dir, int p) { const float dt = expf(a.in[I_lstep][dir * 64 + g]); return (f32x2){a.in[I_are][(dir * 64 + g) * 64 + p] * dt, a.in[I_aim][(dir * 64 + g) * 64 + p] * dt}; }
__device__ __forceinline__ f32x2 cpow(float ardt, float aidt, float n) { const float m = __builtin_amdgcn_exp2f(ardt * n * LOG2E), rev = aidt * n * 0.15915494309189535f; return (f32x2){m * __builtin_amdgcn_cosf(rev), m * __builtin_amdgcn_sinf(rev)}; }

constexpr int CI_WIN0 = 0, CN_WIN0 = (D / 64) * (NIN / 32);
constexpr int CI_WQB = CI_WIN0 + CN_WIN0, CN_WQB = (384 / 64) * (768 / 32);
constexpr int CI_WKVB = CI_WQB + CN_WQB, CN_WKVB = (256 / 64) * (1024 / 32);
constexpr int CI_WOUT = CI_WKVB + CN_WKVB, CN_WOUT = (D / 64) * (D / 32);
constexpr int CI_WFGU = CI_WOUT + CN_WOUT, CN_WFGU = (D / 64) * (5632 / 32);
constexpr int CI_WFD = CI_WFGU + CN_WFGU, CN_WFD = (DFF / 64) * (D / 32);
constexpr int CI_WS5 = CI_WFD + CN_WFD, CN_WS5 = (D / 64) * (D / 32);
constexpr int CI_WGLU = CI_WS5 + CN_WS5, CN_WGLU = (D / 64) * (2048 / 32);
constexpr int CI_MGU = CI_WGLU + CN_WGLU, CN_MGU1 = (D / 64) * (7168 / 32), CN_MGU = NE * CN_MGU1;
constexpr int CI_MD = CI_MGU + CN_MGU, CN_MD1 = (DFE / 64) * (D / 32), CN_MD = NE * CN_MD1;
#ifndef TC_P0
#define TC_P0 1792
#endif
constexpr int CI_KK = CI_MD + CN_MD, CN_KK = 64 * 2 * TCH;
constexpr int CI_BH = CI_KK + CN_KK, CN_BH = 64 * 2;
constexpr int CI_END = CI_BH + CN_BH;

__device__ __forceinline__ ConvItem conv_decode(const Args& a, unsigned char* ws, int it) {
    ConvItem ci;
        if (it < CI_MGU) {
            ConvSrc cs; cs.perm = 0; cs.scale = 1.f; cs.gain = nullptr; bf16_t* dst; int ldd, n0, k0;
            if (it < CI_WQB) { const int r = it - CI_WIN0, nblk = NIN / 32; k0 = 64 * (r / nblk); n0 = 32 * (r % nblk); dst = (bf16_t*)(ws + WS_WIN0); ldd = D;
                cs.src = a.in[I_win]; cs.ld = 2208; cs.col0 = n0 < 2208 ? n0 : -1; cs.perm = (n0 == 640); cs.scale = (n0 >= 672 && n0 < 1184) ? C2_NA : 1.f; }
            else if (it < CI_WKVB) { const int r = it - CI_WQB, nblk = 768 / 32; k0 = 64 * (r / nblk); n0 = 32 * (r % nblk); dst = (bf16_t*)(ws + WS_WQB); ldd = 384;
                cs.src = a.in[I_wqb]; cs.ld = 768; cs.col0 = n0; cs.perm = ((n0 % 96) == 64); cs.gain = a.in[I_qng]; }
            else if (it < CI_WOUT) { const int r = it - CI_WKVB, nblk = 1024 / 32; k0 = 64 * (r / nblk); n0 = 32 * (r % nblk); dst = (bf16_t*)(ws + WS_WKVB); ldd = 256;
                cs.src = a.in[I_wkvb]; cs.ld = 1024; cs.col0 = n0; cs.gain = a.in[I_kvng]; }
            else if (it < CI_WFGU) { const int r = it - CI_WOUT, nblk = D / 32; k0 = 64 * (r / nblk); n0 = 32 * (r % nblk); dst = (bf16_t*)(ws + WS_WOUT); ldd = D; cs.src = a.in[I_wout]; cs.ld = D; cs.col0 = n0; }
            else if (it < CI_WFD) { const int r = it - CI_WFGU, nblk = 5632 / 32; k0 = 64 * (r / nblk); n0 = 32 * (r % nblk); dst = (bf16_t*)(ws + WS_WFGU); ldd = D; cs = gu_src(a.in[I_fg], a.in[I_fu], DFF, n0); }
            else if (it < CI_WS5) { const int r = it - CI_WFD, nblk = D / 32; k0 = 64 * (r / nblk); n0 = 32 * (r % nblk); dst = (bf16_t*)(ws + WS_WFD); ldd = LDF; cs.src = a.in[I_fd]; cs.ld = D; cs.col0 = n0; }
            else if (it < CI_WGLU) { const int r = it - CI_WS5, nblk = D / 32; k0 = 64 * (r / nblk); n0 = 32 * (r % nblk); dst = (bf16_t*)(ws + WS_WS5); ldd = D; cs.src = a.in[I_s5in]; cs.ld = D; cs.col0 = n0; }
            else { const int r = it - CI_WGLU, nblk = 2048 / 32; k0 = 64 * (r / nblk); n0 = 32 * (r % nblk); dst = (bf16_t*)(ws + WS_WGLU); ldd = D; cs = gu_src(a.in[I_wglu], a.in[I_wglu] + 1024, 2048, n0); }
            ci.cs = cs; ci.dst = dst; ci.ldd = ldd; ci.n0 = n0; ci.k0 = k0;
        } else if (it < CI_MD) {
            const int r0 = it - CI_MGU, e = r0 / CN_MGU1, r = r0 % CN_MGU1, nblk = 7168 / 32; const int k0 = 64 * (r / nblk), n0 = 32 * (r % nblk);
            ConvSrc cs = gu_src(a.in[I_mg] + (size_t)e * D * DFE, a.in[I_mu] + (size_t)e * D * DFE, DFE, n0);
            ci.cs = cs; ci.dst = (bf16_t*)(ws + WS_WMOE_GU) + (size_t)e * 7168 * D; ci.ldd = D; ci.n0 = n0; ci.k0 = k0;
        } else if (it < CI_KK) {
            const int r0 = it - CI_MD, e = r0 / CN_MD1, r = r0 % CN_MD1, nblk = D / 32; const int k0 = 64 * (r / nblk), n0 = 32 * (r % nblk);
            ConvSrc cs; cs.src = a.in[I_md] + (size_t)e * DFE * D; cs.ld = D; cs.col0 = n0; cs.perm = 0; cs.scale = 1.f; cs.gain = nullptr;
            ci.cs = cs; ci.dst = (bf16_t*)(ws + WS_WMOE_D) + (size_t)e * D * DFE; ci.ldd = DFE; ci.n0 = n0; ci.k0 = k0;
        }
    return ci;
}
__device__ __forceinline__ void conv4(const Args& a, unsigned char* ws, const int (&it)[4], const bool (&ok)[4], LAS float* scr, int lane) {
    ConvItem ci[4]; f32x4 v[4][8];
#pragma unroll
    for (int i = 0; i < 4; ++i) if (ok[i]) { ci[i] = conv_decode(a, ws, it[i]); conv_load(ci[i], v[i], lane); }
#pragma unroll
    for (int i = 0; i < 4; ++i) if (ok[i]) conv_finish(ci[i], v[i], scr, lane);
}
#ifndef GSEL
#define GSEL -1
#endif
#define GSTAMP(F, k) do { if (GSEL >= 0 && (F).tid == 0) { unsigned long long* gs_ = (unsigned long long*)((F).ws + WS_CTL + CTL_TS + 64); const unsigned long long t_ = wall_clock64(); if ((k) < 0) { if (GSEL < 10) atomicMax(gs_, ~t_); } else if ((k) == GSEL) { atomicMax(gs_ + 1, t_); if (GSEL >= 10) atomicMax(gs_, ~t_); } } } while (0)
__device__ __forceinline__ void p0_prologue(Frame& F, int qsel) {
    const Args& a = *F.a; unsigned char* ws = F.ws;
    {
        LAS float* part = (LAS float*)F.lds;
        LAS float* scnd = part + 8 * 5 * 64;
        float* modp = (float*)(ws + WS_MODP);
        if ((int)blockIdx.x < 2 * 96) {
            for (int i = F.tid; i < 5 * D; i += NTHR) { const int r = i >> 10, k = i & 1023; const float cv = r < 4 ? a.in[I_c][r * D + k] : a.in[I_cctx][k]; scnd[i] = cv * fast_sigmoid(cv); }
            __syncthreads();
        }
        for (int it = blockIdx.x; it < 2 * 96; it += F.G) {
            const int l = it / 96, cb = it % 96, col = cb * 64 + F.lane;
            const float* W = a.in[I_modw] + (size_t)l * D * 6144 + col;
            float acc[5] = {0.f, 0.f, 0.f, 0.f, 0.f};
            const int kb = F.wave * 128;
#pragma unroll 2
            for (int k0 = kb; k0 < kb + 128; k0 += 16) {
                float wv[16];
#pragma unroll
                for (int j = 0; j < 16; ++j) wv[j] = W[(size_t)(k0 + j) * 6144];
#pragma unroll
                for (int j = 0; j < 16; ++j)
#pragma unroll
                    for (int r = 0; r < 5; ++r) acc[r] += scnd[r * D + k0 + j] * wv[j];
            }
#pragma unroll
            for (int r = 0; r < 5; ++r) part[(F.wave * 5 + r) * 64 + F.lane] = acc[r];
            __syncthreads();
            if (F.wave < 5) { const int r = F.wave; float sum = 0.f;
#pragma unroll
                for (int w = 0; w < 8; ++w) sum += part[(w * 5 + r) * 64 + F.lane];
                modp[(l * 5 + r) * 6144 + col] = sum + a.in[I_modb][l * 6144 + col]; }
            asm volatile("s_waitcnt vmcnt(0)" ::: "memory");
            __syncthreads();
            if (F.tid == 0) { __builtin_amdgcn_fence(__ATOMIC_RELEASE, "agent"); asm volatile("s_waitcnt vmcnt(0)" ::: "memory");
                (void)__hip_atomic_fetch_add((unsigned*)(ws + WS_CTL + CTL_ADALN), 1u, __ATOMIC_RELAXED, __HIP_MEMORY_SCOPE_AGENT); }
        }
    }
    GSTAMP(F, 0);
    LAS float* scr = (LAS float*)(F.lds + F.wave * 16384);
    const int gw = F.vcu * NWAVES + F.wave, NGW = F.G * NWAVES, lane = F.lane;
    unsigned* qctr = (unsigned*)(ws + WS_CTL + CTL_Q0) + 64 * qsel;
    const int conv_end = F.tailconv ? CI_MGU + 8 * TC_P0 : CI_KK;
    constexpr int QB_KK = CN_BH / 8, QB_CONV = QB_KK + CN_KK / 32; const int QB_END = QB_CONV + (conv_end + 127) / 128;
    constexpr int QC_KK = CN_BH, QC_CONV = QC_KK + CN_KK / 4;
    volatile LAS int* qslot = (volatile LAS int*)(F.lds + LDS_MISC + 64);
    for (;;) {
      __syncthreads();
      if (F.tid == 0) qslot[0] = (int)__hip_atomic_fetch_add(qctr, 1u, __ATOMIC_RELAXED, __HIP_MEMORY_SCOPE_AGENT);
      __syncthreads();
      const int cbk = __builtin_amdgcn_readfirstlane(qslot[0]); if (cbk >= QB_END) break;
      const int c = cbk < QB_KK ? cbk * 8 + F.wave : (cbk < QB_CONV ? QC_KK + (cbk - QB_KK) * 8 + F.wave : QC_CONV + (cbk - QB_CONV));
      if (c < QC_KK) { const int it = c;
            const int r = it, g = r >> 1, dir = r & 1, p = lane;
            const f32x4 dsc = s5_disc(a, g, dir, p);
            float br[16], bi[16];
            const float* bre = a.in[I_bre] + ((size_t)(dir * 64 + g) * 64 + p) * 16; const float* bim = a.in[I_bim] + ((size_t)(dir * 64 + g) * 64 + p) * 16;
#pragma unroll
            for (int i = 0; i < 16; ++i) { const float x = bre[i], y = bim[i]; br[i] = dsc.z * x - dsc.w * y; bi[i] = dsc.z * y + dsc.w * x; }
            bf16_t* rowr = (bf16_t*)(ws + WS_BHAT) + ((size_t)g * 256 + dir * 128 + p) * SK; bf16_t* rowi = rowr + (size_t)64 * SK;
            const f32x2 a1 = cpow(dsc.x, dsc.y, 1.f); f32x2 ap = (f32x2){1.f, 0.f};
            for (int e = 0; e < TCH; ++e) {
                const int s = dir ? e : TCH - 1 - e;
                u32x4 o0, o1, q0, q1; float vr[16], vi[16];
#pragma unroll
                for (int i = 0; i < 16; ++i) { vr[i] = ap.x * br[i] - ap.y * bi[i]; vi[i] = ap.x * bi[i] + ap.y * br[i]; }
                o0 = (u32x4){cvt_pk_bf16(vr[0], vr[1]), cvt_pk_bf16(vr[2], vr[3]), cvt_pk_bf16(vr[4], vr[5]), cvt_pk_bf16(vr[6], vr[7])}; o1 = (u32x4){cvt_pk_bf16(vr[8], vr[9]), cvt_pk_bf16(vr[10], vr[11]), cvt_pk_bf16(vr[12], vr[13]), cvt_pk_bf16(vr[14], vr[15])};
                q0 = (u32x4){cvt_pk_bf16(vi[0], vi[1]), cvt_pk_bf16(vi[2], vi[3]), cvt_pk_bf16(vi[4], vi[5]), cvt_pk_bf16(vi[6], vi[7])}; q1 = (u32x4){cvt_pk_bf16(vi[8], vi[9]), cvt_pk_bf16(vi[10], vi[11]), cvt_pk_bf16(vi[12], vi[13]), cvt_pk_bf16(vi[14], vi[15])};
                *(u32x4*)(rowr + s * 16) = o0; *(u32x4*)(rowr + s * 16 + 8) = o1; *(u32x4*)(rowi + s * 16) = q0; *(u32x4*)(rowi + s * 16 + 8) = q1;
                ap = (f32x2){ap.x * a1.x - ap.y * a1.y, ap.x * a1.y + ap.y * a1.x};
            }
      } else if (c < QC_CONV) {
        const int ck = c - QC_KK, g = ck >> 4, dir = (ck >> 3) & 1, tau0 = (ck & 7) * 4;
        { const f32x4* s0 = (const f32x4*)(a.in[I_cre] + (size_t)(dir * 64 + g) * 1024); const f32x4* s1 = (const f32x4*)(a.in[I_cim] + (size_t)(dir * 64 + g) * 1024);
          const f32x4* s2 = (const f32x4*)(a.in[I_bre] + (size_t)(dir * 64 + g) * 1024); const f32x4* s3 = (const f32x4*)(a.in[I_bim] + (size_t)(dir * 64 + g) * 1024);
          f32x4 t0[4], t1[4], t2[4], t3[4];
#pragma unroll
          for (int j = 0; j < 4; ++j) { t0[j] = s0[lane + 64 * j]; t1[j] = s1[lane + 64 * j]; t2[j] = s2[lane + 64 * j]; t3[j] = s3[lane + 64 * j]; }
#pragma unroll
          for (int j = 0; j < 4; ++j) { ((LAS f32x4*)scr)[lane + 64 * j] = t0[j]; ((LAS f32x4*)scr)[256 + lane + 64 * j] = t1[j]; ((LAS f32x4*)scr)[512 + lane + 64 * j] = t2[j]; ((LAS f32x4*)scr)[768 + lane + 64 * j] = t3[j]; } }
        asm volatile("s_waitcnt lgkmcnt(0)" ::: "memory");
        const f32x4 dsc = s5_disc(a, g, dir, lane);
        const int o = lane >> 2, i0 = 4 * (lane & 3);
        const LAS float* Cr = scr + o * 64; const LAS float* Ci = scr + 1024 + o * 64; const LAS float* Br = scr + 2048 + i0; const LAS float* Bi = scr + 3072 + i0;
        for (int tt = 0; tt < 4; ++tt) {
            const int tau = tau0 + tt;
            const f32x2 ap = cpow(dsc.x, dsc.y, (float)tau);
            const float gr_ = ap.x * dsc.z - ap.y * dsc.w, gi_ = ap.x * dsc.w + ap.y * dsc.z;
            f32x4 acc = (f32x4){0.f, 0.f, 0.f, 0.f};
#pragma unroll 8
            for (int p = 0; p < 64; ++p) {
                const float xr = __builtin_bit_cast(float, __builtin_amdgcn_readlane(__builtin_bit_cast(int, gr_), p)), xi = __builtin_bit_cast(float, __builtin_amdgcn_readlane(__builtin_bit_cast(int, gi_), p));
                const float cr = Cr[p], ci = Ci[p];
                const float hr = cr * xr - ci * xi, hi = cr * xi + ci * xr;
                const f32x4 br = *(const LAS f32x4*)(Br + p * 16), bi = *(const LAS f32x4*)(Bi + p * 16);
                acc += hr * br - hi * bi;
            }
            *(f32x4*)((float*)(ws + WS_KKER) + ((size_t)((g * 2 + dir) * 16 + o) * TCH + tau) * 16 + i0) = acc;
        }
        asm volatile("s_waitcnt lgkmcnt(0)" ::: "memory");
      } else {
        const int itb = (c - QC_CONV) * 128 + F.wave; const int ite = ((c - QC_CONV) * 128 + 128 < conv_end) ? (c - QC_CONV) * 128 + 128 : conv_end;
        for (int it0 = itb; it0 < ite; it0 += 32) {
            int it[4]; bool ok[4];
#pragma unroll
            for (int i = 0; i < 4; ++i) { it[i] = it0 + 8 * i; ok[i] = it[i] < ite; }
            conv4(a, ws, it, ok, scr, lane);
        }
      }
    }
    GSTAMP(F, 1);
    (void)gw; (void)NGW;
}

constexpr int TC_CHUNKS = (CI_KK - CI_MGU) / 8;
__device__ __forceinline__ void tail_convert(Frame& F, int cb, int ce, int j, int n_idle) {
    const Args& a = *F.a; unsigned char* ws = F.ws; LAS float* scr = (LAS float*)(F.lds + F.wave * 16384); const int lane = F.lane;
    if (ce > TC_CHUNKS) ce = TC_CHUNKS;
    for (int ch = cb + j; ch < ce; ch += 4 * n_idle) {
        int it[4]; bool ok[4];
#pragma unroll
        for (int i = 0; i < 4; ++i) { const int c = ch + i * n_idle; ok[i] = c < ce; it[i] = CI_MGU + c * 8 + F.wave; }
        conv4(a, ws, it, ok, scr, lane);
    }
}
__device__ __forceinline__ f32x4 bf4_to_f32(u32x2 p) { return (f32x4){bf_lo(p.x), bf_hi(p.x), bf_lo(p.y), bf_hi(p.y)}; }
__device__ __forceinline__ void load_modtab(const Frame& F, LAS float* tab, int c0, int nc, const float* gate0, const float* sh0, const float* sc0, const float* g) {
    for (int i = F.tid; i < nc * 256; i += NTHR) { const int c = c0 + (i >> 8), k4 = i & 255; LAS f32x4* t = (LAS f32x4*)(tab + (size_t)(i >> 8) * 3072);
        const f32x4 gn = ((const f32x4*)g)[k4];
        const f32x4 gt = gate0 ? ((const f32x4*)(gate0 + (size_t)c * 6144))[k4] : (f32x4){0.f, 0.f, 0.f, 0.f};
        const f32x4 s0 = sh0 ? ((const f32x4*)(sh0 + (size_t)c * 6144))[k4] : (f32x4){0.f, 0.f, 0.f, 0.f};
        const f32x4 s1 = sc0 ? ((const f32x4*)(sc0 + (size_t)c * 6144))[k4] : (f32x4){0.f, 0.f, 0.f, 0.f};
        t[k4] = gt; t[256 + k4] = s0; t[512 + k4] = gn * (1.f + s1); }
    __syncthreads();
}
template <int NR, bool RES, bool TO_LDS = false, bool XIB = false>
__device__ __forceinline__ void modulate_rows(const float* const (&xrow)[NR], const bf16_t* const (&yrow)[NR], const LAS float* const (&tb)[NR], float* const (&xout)[NR],
                                              bf16_t* const (&orow)[NR], int lane, f32x4 (&v)[NR][4], LAS u32x2* const* lrow = nullptr) {
    u32x2 yv[NR][4], xb[NR][4];
#pragma unroll
    for (int r = 0; r < NR; ++r) if (xrow[r]) {
#pragma unroll
        for (int j = 0; j < 4; ++j) { if (XIB) xb[r][j] = ((const u32x2*)xrow[r])[lane + 64 * j]; else v[r][j] = ((const f32x4*)xrow[r])[lane + 64 * j]; if (RES) yv[r][j] = ((const u32x2*)yrow[r])[lane + 64 * j]; } }
#pragma unroll
    for (int r = 0; r < NR; ++r) if (xrow[r]) {
        float s = 0.f;
#pragma unroll
        for (int j = 0; j < 4; ++j) {
            if (XIB) v[r][j] = bf4_to_f32(xb[r][j]);
            if (RES) { const f32x4 gt = ((const LAS f32x4*)tb[r])[lane + 64 * j]; v[r][j] = v[r][j] + gt * bf4_to_f32(yv[r][j]); ((f32x4*)xout[r])[lane + 64 * j] = v[r][j]; }
            s += (v[r][j].x * v[r][j].x + v[r][j].y * v[r][j].y) + (v[r][j].z * v[r][j].z + v[r][j].w * v[r][j].w); }
        const float rs = rsqrtf(wave_sum(s) * (1.f / D) + EPS);
#pragma unroll
        for (int j = 0; j < 4; ++j) { const f32x4 s0 = ((const LAS f32x4*)(tb[r] + 1024))[lane + 64 * j], a1 = ((const LAS f32x4*)(tb[r] + 2048))[lane + 64 * j];
            v[r][j] = v[r][j] * rs * a1 + s0;
            const u32x2 pk = (u32x2){cvt_pk_bf16(v[r][j].x, v[r][j].y), cvt_pk_bf16(v[r][j].z, v[r][j].w)};
            if (TO_LDS) lrow[r][lane + 64 * j] = pk; else *((u32x2*)orow[r] + lane + 64 * j) = pk; }
    }
}
struct RowRegs { f32x4 x[4]; u32x2 y[4]; u32x2 xb[4]; };
template <bool RES, bool XIB = false>
__device__ __forceinline__ void load_row(RowRegs& R, const void* xin, const bf16_t* yrow, int lane) {
#pragma unroll
    for (int j = 0; j < 4; ++j) { if (XIB) R.xb[j] = ((const u32x2*)xin)[lane + 64 * j]; else R.x[j] = ((const f32x4*)xin)[lane + 64 * j]; if (RES) R.y[j] = ((const u32x2*)yrow)[lane + 64 * j]; }
}
template <bool RES, bool XIB = false, bool XOB = false>
__device__ __forceinline__ void finish_row(RowRegs& R, const LAS float* tb, void* xout, bf16_t* orow, int lane) {
    float s = 0.f;
#pragma unroll
    for (int j = 0; j < 4; ++j) {
        if (XIB) R.x[j] = bf4_to_f32(R.xb[j]);
        if (RES) { const f32x4 gt = ((const LAS f32x4*)tb)[lane + 64 * j]; R.x[j] = R.x[j] + gt * bf4_to_f32(R.y[j]);
            if (XOB) ((u32x2*)xout)[lane + 64 * j] = (u32x2){cvt_pk_bf16(R.x[j].x, R.x[j].y), cvt_pk_bf16(R.x[j].z, R.x[j].w)}; else ((f32x4*)xout)[lane + 64 * j] = R.x[j]; }
        s += (R.x[j].x * R.x[j].x + R.x[j].y * R.x[j].y) + (R.x[j].z * R.x[j].z + R.x[j].w * R.x[j].w); }
    const float rs = rsqrtf(wave_sum(s) * (1.f / D) + EPS);
#pragma unroll
    for (int j = 0; j < 4; ++j) { const f32x4 s0 = ((const LAS f32x4*)(tb + 1024))[lane + 64 * j], a1 = ((const LAS f32x4*)(tb + 2048))[lane + 64 * j];
        const f32x4 o = R.x[j] * rs * a1 + s0;
        *((u32x2*)orow + lane + 64 * j) = (u32x2){cvt_pk_bf16(o.x, o.y), cvt_pk_bf16(o.z, o.w)}; }
}
__device__ __forceinline__ void ctx_row_part(const float* xin, float* xout, const float* part, int S, int r, const LAS float* tb, bf16_t* orow, int lane) {
    f32x4 v[4], y[4];
#pragma unroll
    for (int j = 0; j < 4; ++j) { v[j] = ((const f32x4*)xin)[lane + 64 * j]; y[j] = (f32x4){0.f, 0.f, 0.f, 0.f}; }
    for (int s = 0; s < S; ++s) { const f32x4* pp = (const f32x4*)(part + ((size_t)s * MC + r) * D);
#pragma unroll
        for (int j = 0; j < 4; ++j) y[j] += pp[lane + 64 * j]; }
    float ss = 0.f;
#pragma unroll
    for (int j = 0; j < 4; ++j) { v[j] = v[j] + ((const LAS f32x4*)tb)[lane + 64 * j] * y[j]; ((f32x4*)xout)[lane + 64 * j] = v[j]; ss += (v[j].x * v[j].x + v[j].y * v[j].y) + (v[j].z * v[j].z + v[j].w * v[j].w); }
    const float rs = rsqrtf(wave_sum(ss) * (1.f / D) + EPS);
#pragma unroll
    for (int j = 0; j < 4; ++j) { const f32x4 o = v[j] * rs * ((const LAS f32x4*)(tb + 2048))[lane + 64 * j] + ((const LAS f32x4*)(tb + 1024))[lane + 64 * j];
        *((u32x2*)orow + lane + 64 * j) = (u32x2){cvt_pk_bf16(o.x, o.y), cvt_pk_bf16(o.z, o.w)}; }
}
__device__ __forceinline__ const float* xrow_ptr(const Frame& F, int row) { return row < ML ? F.a->out + (size_t)row * D : (const float*)(F.ws + WS_XC) + (size_t)(row - ML) * D; }

__device__ __forceinline__ void lt_expand(Frame& F, int first, int stride) {
    const Args& a = *F.a; unsigned char* ws = F.ws; const int lane = F.lane;
    const float* KK = (const float*)(ws + WS_KKER);
    for (int it = first; it < 64 * TCH; it += stride) {
        const int g = it / TCH, t = it % TCH;
        bf16_t* base = (bf16_t*)(ws + WS_LT) + ((size_t)g * 512 + t * 16) * SKA;
        const int s = lane >> 1, i0 = (lane & 1) * 8;
        const int sdir = lane >> 5, scomp = (lane >> 4) & 1, p0 = 4 * (lane & 15);
        f32x2 ap[4];
#pragma unroll
        for (int j = 0; j < 4; ++j) { const f32x2 ad = s5_adt(a, g, sdir, p0 + j); ap[j] = cpow(ad.x, ad.y, (float)(sdir ? TCH - t : t + 1)); }
        const float mf = (t >= s) ? 1.f : 0.f, mr = (t <= s) ? 1.f : 0.f; const int df = t >= s ? t - s : 0, dr = s >= t ? s - t : 0;
        const float* kf0 = KK + ((size_t)((g * 2 + 0) * 16) * TCH + df) * 16 + i0; const float* kr0 = KK + ((size_t)((g * 2 + 1) * 16) * TCH + dr) * 16 + i0;
        const float* cre0 = a.in[I_cre] + (size_t)((sdir * 64 + g) * 16) * 64 + p0; const float* cim0 = a.in[I_cim] + (size_t)((sdir * 64 + g) * 16) * 64 + p0;
        for (int ob = 0; ob < 16; ob += 4) {
            f32x4 a0[4], a1[4], b0[4], b1[4], cr4[4], ci4[4];
#pragma unroll
            for (int k = 0; k < 4; ++k) { const int o = ob + k; a0[k] = *(const f32x4*)(kf0 + o * TCH * 16); a1[k] = *(const f32x4*)(kf0 + o * TCH * 16 + 4); b0[k] = *(const f32x4*)(kr0 + o * TCH * 16); b1[k] = *(const f32x4*)(kr0 + o * TCH * 16 + 4);
                cr4[k] = *(const f32x4*)(cre0 + o * 64); ci4[k] = *(const f32x4*)(cim0 + o * 64); }
#pragma unroll
            for (int k = 0; k < 4; ++k) { const int o = ob + k;
                const f32x4 lo = mf * a0[k] + mr * b0[k], hi = mf * a1[k] + mr * b1[k];
                bf16_t* rowp = base + (size_t)o * SKA;
                *(u32x4*)(rowp + s * 16 + i0) = (u32x4){cvt_pk_bf16(lo.x, lo.y), cvt_pk_bf16(lo.z, lo.w), cvt_pk_bf16(hi.x, hi.y), cvt_pk_bf16(hi.z, hi.w)};
                float w[4];
#pragma unroll
                for (int j = 0; j < 4; ++j) { const float cr = cr4[k][j], ci = ci4[k][j]; w[j] = scomp ? -(cr * ap[j].y + ci * ap[j].x) : (cr * ap[j].x - ci * ap[j].y); }
                *(u32x2*)(rowp + SK + 4 * lane) = (u32x2){cvt_pk_bf16(w[0], w[1]), cvt_pk_bf16(w[2], w[3])}; }
        }
    }
}

__device__ __forceinline__ void p1_phase(Frame& F) {
    const Args& a = *F.a; unsigned char* ws = F.ws; const int gw = F.vcu * NWAVES + F.wave, NGW = F.G * NWAVES, lane = F.lane;
    const float* modp = (const float*)(ws + WS_MODP);
    if (F.wait_adaln) {
        if (F.tid == 0) { unsigned* cnt = (unsigned*)(ws + WS_CTL + CTL_ADALN); unsigned sp = 0;
            while (__hip_atomic_load(cnt, __ATOMIC_RELAXED, __HIP_MEMORY_SCOPE_AGENT) < 192u) { __builtin_amdgcn_s_sleep(2); if (++sp > (1u << 20)) break; }
            __builtin_amdgcn_fence(__ATOMIC_ACQUIRE, "agent"); asm volatile("s_waitcnt vmcnt(0)" ::: "memory"); }
        __syncthreads();
    }
    LAS float* tab = (LAS float*)F.lds;
    load_modtab(F, tab, 0, NB + 1, nullptr, modp, modp + 1024, a.in[I_n1g]);
    bf16_t* HBp = (bf16_t*)(ws + WS_HB);
    { RowRegs A0, A1, B0, B1;
#define P1_LOAD(R, k) load_row<false>(R, a.in[I_x] + (size_t)(gw + (k) * NGW) * D, nullptr, lane)
#define P1_FIN(R, k) do { const int rw_ = gw + (k) * NGW; finish_row<false>(R, tab + (size_t)(rw_ / SEQ) * 3072, nullptr, HBp + (size_t)rw_ * D, lane); } while (0)
      if (gw + 7 * NGW < ML) {
        P1_LOAD(A0, 0); P1_LOAD(A1, 1); P1_LOAD(B0, 2); P1_LOAD(B1, 3);
        P1_FIN(A0, 0); P1_FIN(A1, 1); P1_LOAD(A0, 4); P1_LOAD(A1, 5);
        P1_FIN(B0, 2); P1_FIN(B1, 3); P1_LOAD(B0, 6); P1_LOAD(B1, 7);
        P1_FIN(A0, 4); P1_FIN(A1, 5);
        if (gw < MC) { load_row<false>(A0, a.in[I_ctx] + (size_t)gw * D, nullptr, lane); P1_FIN(B0, 6); P1_FIN(B1, 7); finish_row<false>(A0, tab + (size_t)NB * 3072, nullptr, HBp + (size_t)(ML + gw) * D, lane); }
        else { P1_FIN(B0, 6); P1_FIN(B1, 7); }
      } else {
        for (int kk = 0; gw + kk * NGW < ML; ++kk) { P1_LOAD(A0, kk); P1_FIN(A0, kk); }
        for (int r = gw; r < MC; r += NGW) { load_row<false>(A0, a.in[I_ctx] + (size_t)r * D, nullptr, lane); finish_row<false>(A0, tab + (size_t)NB * 3072, nullptr, HBp + (size_t)(ML + r) * D, lane); }
      }
#undef P1_LOAD
#undef P1_FIN
    }
    __syncthreads();
#ifndef LT_IN_P1
#define LT_IN_P1 0
#endif
    if (!F.tailconv || LT_IN_P1) lt_expand(F, gw, NGW);
}
}
namespace fp {
using pg8::Unit;
typedef f32x4 Acc[2][2][4][2];
#ifndef WT_STORE
#define WT_STORE 0
#endif
__device__ __forceinline__ void st16(bf16_t* base, size_t elem_off, u32x4 v, __amdgpu_buffer_rsrc_t rs) {
    if (WT_STORE) __builtin_amdgcn_raw_buffer_store_b128(v, rs, (int)(unsigned)(elem_off * 2), 0, 16); else *(u32x4*)(base + elem_off) = v; }
__device__ __forceinline__ __amdgpu_buffer_rsrc_t mk_rsrc(const void* p, unsigned nbytes) { return __builtin_amdgcn_make_buffer_rsrc((void*)p, (short)0, (int)nbytes, 0x00020000); }
#define EPI_ROWS_BEGIN _Pragma("unroll") for (int ai = 0; ai < 2; ++ai) _Pragma("unroll") for (int m = 0; m < 4; ++m) { const int tr = 128 * ai + 64 * wr + 16 * m + fr;
#define EPI_ROWS_END }

struct SchedPlain {
    pg8::Order o; const bf16_t* A; const bf16_t* Bt; int lda, ldb, nt;
    __device__ __forceinline__ int ktiles(const Unit&) const { return nt; }
    __device__ __forceinline__ bool next(int i, Unit& u) const { return o.next(i, u); }
    __device__ __forceinline__ const char* aptr(const Unit& u) const { return (const char*)(A + (size_t)u.pm * 256 * lda); }
    __device__ __forceinline__ const char* bptr(const Unit& u) const { return (const char*)(Bt + (size_t)u.pn * 256 * ldb); }
};

struct EpiInProj {
    bf16_t* P; float* ssq; bf16_t* Kf; const LAS f32x2* rope;
    __device__ __forceinline__ void operator()(const Acc& acc, const Unit& u, int wr, int wc, int fr, int fq) const {
        EPI_ROWS_BEGIN
            const int row = u.pm * 256 + tr;
#pragma unroll
            for (int bj = 0; bj < 2; ++bj) {
                const int col8 = u.pn * 256 + 128 * bj + 32 * wc + 8 * fq;
                const f32x4 v0 = acc[ai][bj][m][0], v1 = acc[ai][bj][m][1];
                *(u32x4*)(P + (size_t)row * NIN + col8) = (u32x4){cvt_pk_bf16(v0[0], v0[1]), cvt_pk_bf16(v0[2], v0[3]), cvt_pk_bf16(v1[0], v1[1]), cvt_pk_bf16(v1[2], v1[3])};
                const int cb = u.pn * 2 + bj;
                if (cb < 5) {
                    float s = (v0[0] * v0[0] + v0[1] * v0[1]) + (v0[2] * v0[2] + v0[3] * v0[3]) + (v1[0] * v1[0] + v1[1] * v1[1]) + (v1[2] * v1[2] + v1[3] * v1[3]);
                    s += __shfl_xor(s, 16); s += __shfl_xor(s, 32);
                    if (fq == 0) ssq[(size_t)row * 20 + cb * 4 + wc] = s;
                } else if (cb == 5 && wc == 0) {
                    float x[8] = {v0[0], v0[1], v0[2], v0[3], v1[0], v1[1], v1[2], v1[3]};
                    if (row < ML) { const int t = row & (SEQ - 1), gr = t >> 6, gc = t & 63;
#pragma unroll
                        for (int e = 0; e < 4; ++e) { const int pi = 4 * fq + e; const f32x2 cs = rope[(pi < 8 ? gr : gc) * 8 + (pi & 7)]; const float x1 = x[2 * e], x2 = x[2 * e + 1]; x[2 * e] = x1 * cs.x - x2 * cs.y; x[2 * e + 1] = x1 * cs.y + x2 * cs.x; } }
                    const u32x4 w = (u32x4){cvt_pk_bf16(x[0], x[1]), cvt_pk_bf16(x[2], x[3]), cvt_pk_bf16(x[4], x[5]), cvt_pk_bf16(x[6], x[7])};
#pragma unroll
                    for (int h = 0; h < 8; ++h) *(u32x4*)(Kf + (size_t)row * 768 + h * 96 + 64 + 8 * fq) = w;
                }
            }
        EPI_ROWS_END
    }
};
struct EpiQb {
    bf16_t* Q; const float* ssq; const LAS f32x2* rope;
    __device__ __forceinline__ void operator()(const Acc& acc, const Unit& u, int wr, int wc, int fr, int fq) const {
        EPI_ROWS_BEGIN
            const int row = u.pm * 256 + tr; const f32x4 q0 = *(const f32x4*)(ssq + (size_t)row * 20), q1 = *(const f32x4*)(ssq + (size_t)row * 20 + 4), q2 = *(const f32x4*)(ssq + (size_t)row * 20 + 8);
            const float rs = rsqrtf((((q0[0] + q0[1]) + (q0[2] + q0[3])) + ((q1[0] + q1[1]) + (q1[2] + q1[3])) + ((q2[0] + q2[1]) + (q2[2] + q2[3]))) * (1.f / 384.f) + EPS) * C2_MLA;
            const int t = row & (SEQ - 1), gr = t >> 6, gc = t & 63;
#pragma unroll
            for (int bj = 0; bj < 2; ++bj) {
                const int col8 = u.pn * 256 + 128 * bj + 32 * wc + 8 * fq; const int d0 = col8 % 96;
                const f32x4 v0 = acc[ai][bj][m][0] * rs, v1 = acc[ai][bj][m][1] * rs;
                float x[8] = {v0[0], v0[1], v0[2], v0[3], v1[0], v1[1], v1[2], v1[3]};
                if (d0 >= 64 && row < ML) { const int pb = (d0 - 64) >> 1;
#pragma unroll
                    for (int e = 0; e < 4; ++e) { const int pi = pb + e; const f32x2 cs = rope[(pi < 8 ? gr : gc) * 8 + (pi & 7)]; const float x1 = x[2 * e], x2 = x[2 * e + 1]; x[2 * e] = x1 * cs.x - x2 * cs.y; x[2 * e + 1] = x1 * cs.y + x2 * cs.x; } }
                *(u32x4*)(Q + (size_t)row * 768 + col8) = (u32x4){cvt_pk_bf16(x[0], x[1]), cvt_pk_bf16(x[2], x[3]), cvt_pk_bf16(x[4], x[5]), cvt_pk_bf16(x[6], x[7])};
            }
        EPI_ROWS_END
    }
};
struct EpiKvb {
    bf16_t* Kf; bf16_t* V; const float* ssq;
    __device__ __forceinline__ void operator()(const Acc& acc, const Unit& u, int wr, int wc, int fr, int fq) const {
        EPI_ROWS_BEGIN
            const int row = u.pm * 256 + tr; const f32x4 q0 = *(const f32x4*)(ssq + (size_t)row * 20 + 12), q1 = *(const f32x4*)(ssq + (size_t)row * 20 + 16);
            const float rs = rsqrtf((((q0[0] + q0[1]) + (q0[2] + q0[3])) + ((q1[0] + q1[1]) + (q1[2] + q1[3]))) * (1.f / 256.f) + EPS);
#pragma unroll
            for (int bj = 0; bj < 2; ++bj) {
                const int col8 = u.pn * 256 + 128 * bj + 32 * wc + 8 * fq; const int h = col8 >> 7, d0 = col8 & 127;
                const f32x4 v0 = acc[ai][bj][m][0] * rs, v1 = acc[ai][bj][m][1] * rs;
                const u32x4 w = (u32x4){cvt_pk_bf16(v0[0], v0[1]), cvt_pk_bf16(v0[2], v0[3]), cvt_pk_bf16(v1[0], v1[1]), cvt_pk_bf16(v1[2], v1[3])};
                if (d0 < 64) *(u32x4*)(Kf + (size_t)row * 768 + h * 96 + d0) = w; else *(u32x4*)(V + (size_t)row * 512 + h * 64 + (d0 - 64)) = w;
            }
        EPI_ROWS_END
    }
};
struct EpiResid {
    const float* xin_l; const float* xin_c; float* xout_l; float* xout_c; const float* gate;
    __device__ __forceinline__ void operator()(const Acc& acc, const Unit& u, int wr, int wc, int fr, int fq) const {
        const bool lat = u.pm < 64; const float* xin = lat ? xin_l + (size_t)u.pm * 256 * D : xin_c + (size_t)(u.pm - 64) * 256 * D; float* xout = lat ? xout_l + (size_t)u.pm * 256 * D : xout_c + (size_t)(u.pm - 64) * 256 * D;
        const float* gt = gate + (size_t)cond_of_tile(u.pm) * 6144;
#pragma unroll
        for (int bj = 0; bj < 2; ++bj) {
            const int col8 = u.pn * 256 + 128 * bj + 32 * wc + 8 * fq; const f32x4 g0 = *(const f32x4*)(gt + col8), g1 = *(const f32x4*)(gt + col8 + 4);
            EPI_ROWS_BEGIN
                const size_t off = (size_t)tr * D + col8; const f32x4 x0 = *(const f32x4*)(xin + off), x1 = *(const f32x4*)(xin + off + 4);
                *(f32x4*)(xout + off) = x0 + g0 * acc[ai][bj][m][0]; *(f32x4*)(xout + off + 4) = x1 + g1 * acc[ai][bj][m][1];
            EPI_ROWS_END
        }
    }
};
struct EpiSwiglu {
    bf16_t* O; int ldo; int ncol_tiles; unsigned nbytes;
    __device__ __forceinline__ void operator()(const Acc& acc, const Unit& u, int wr, int wc, int fr, int fq) const {
        const int col8 = (u.pn % ncol_tiles) * 128 + 32 * wc + 8 * fq; const __amdgpu_buffer_rsrc_t rs = mk_rsrc(O, nbytes);
        EPI_ROWS_BEGIN
            const size_t row = (size_t)u.pm * 256 + tr; float o[8];
#pragma unroll
            for (int n = 0; n < 2; ++n)
#pragma unroll
                for (int j = 0; j < 4; ++j) { const float g = acc[ai][0][m][n][j], up = acc[ai][1][m][n][j]; o[4 * n + j] = g * fast_sigmoid(g) * up; }
            st16(O, row * ldo + col8, (u32x4){cvt_pk_bf16(o[0], o[1]), cvt_pk_bf16(o[2], o[3]), cvt_pk_bf16(o[4], o[5]), cvt_pk_bf16(o[6], o[7])}, rs);
        EPI_ROWS_END
    }
};
struct EpiS5In {
    bf16_t* acat; bf16_t* acatc;
    __device__ __forceinline__ void operator()(const Acc& acc, const Unit& u, int wr, int wc, int fr, int fq) const {
        EPI_ROWS_BEGIN
            const int row = u.pm * 256 + tr;
#pragma unroll
            for (int bj = 0; bj < 2; ++bj) {
                const int col8 = u.pn * 256 + 128 * bj + 32 * wc + 8 * fq; const int g = col8 >> 4, i0 = col8 & 15;
                const f32x4 v0 = acc[ai][bj][m][0], v1 = acc[ai][bj][m][1];
                const u32x4 w = (u32x4){cvt_pk_bf16(v0[0], v0[1]), cvt_pk_bf16(v0[2], v0[3]), cvt_pk_bf16(v1[0], v1[1]), cvt_pk_bf16(v1[2], v1[3])};
                if (row < ML) *(u32x4*)(acat + ((size_t)g * 512 + (row >> 5)) * SKA + (row & 31) * 16 + i0) = w;
                else { const int j = row - ML; *(u32x4*)(acatc + ((size_t)g * 32 + (j >> 5)) * SKA + (j & 31) * 16 + i0) = w; }
            }
        EPI_ROWS_END
    }
};
struct SchedSloc {
    pg8::Order o; const bf16_t* acat; const bf16_t* acatc; const bf16_t* bhat;
    __device__ __forceinline__ int ktiles(const Unit&) const { return SK / 64; }
    __device__ __forceinline__ bool next(int i, Unit& u) const { return o.next(i, u); }
    __device__ __forceinline__ const char* aptr(const Unit& u) const { const int g = u.pm / 3, rt = u.pm % 3; return (const char*)(rt < 2 ? acat + ((size_t)g * 512 + rt * 256) * SKA : acatc + (size_t)g * 32 * SKA); }
    __device__ __forceinline__ const char* bptr(const Unit& u) const { return (const char*)(bhat + (size_t)(u.pm / 3) * 256 * SK); }
};
struct EpiSloc {
    float* sloc;
    __device__ __forceinline__ void operator()(const Acc& acc, const Unit& u, int wr, int wc, int fr, int fq) const {
        const int g = u.pm / 3, rt = u.pm % 3;
        EPI_ROWS_BEGIN
            if (rt < 2 || tr < 32) {
                float* rp = sloc + ((size_t)g * 544 + rt * 256 + tr) * 256;
#pragma unroll
                for (int bj = 0; bj < 2; ++bj) { const int col8 = 128 * bj + 32 * wc + 8 * fq; *(f32x4*)(rp + col8) = acc[ai][bj][m][0]; *(f32x4*)(rp + col8 + 4) = acc[ai][bj][m][1]; }
            }
        EPI_ROWS_END
    }
};
struct SchedS5Out {
    pg8::Order o; const bf16_t* acat; const bf16_t* lt;
    __device__ __forceinline__ int ktiles(const Unit&) const { return SKA / 64; }
    __device__ __forceinline__ bool next(int i, Unit& u) const { return o.next(i, u); }
    __device__ __forceinline__ const char* aptr(const Unit& u) const { return (const char*)(acat + ((size_t)(u.pm >> 1) * 512 + (u.pm & 1) * 256) * SKA); }
    __device__ __forceinline__ const char* bptr(const Unit& u) const { return (const char*)(lt + ((size_t)(u.pm >> 1) * 512 + u.pn * 256) * SKA); }
};
__device__ __forceinline__ float gelu_tanh_fast(float x) { const float uu = 0.7978845608028654f * (x + 0.044715f * x * x * x); return x * __builtin_amdgcn_rcpf(1.f + __builtin_amdgcn_exp2f(-2.f * LOG2E * uu)); }
struct EpiS5Out {
    const bf16_t* acat; const float* dskip; bf16_t* gb;
    __device__ __forceinline__ void operator()(const Acc& acc, const Unit& u, int wr, int wc, int fr, int fq) const {
        const int g = u.pm >> 1, rm = u.pm & 1;
        f32x4 dd[2][2];
#pragma unroll
        for (int bj = 0; bj < 2; ++bj) { const int o0 = (u.pn * 256 + 128 * bj + 32 * wc + 8 * fq) & 15; dd[bj][0] = *(const f32x4*)(dskip + g * 16 + o0); dd[bj][1] = *(const f32x4*)(dskip + g * 16 + o0 + 4); }
#pragma unroll
        for (int ai = 0; ai < 2; ++ai) {
            u32x4 uw[4][2];
#pragma unroll
            for (int m = 0; m < 4; ++m)
#pragma unroll
                for (int bj = 0; bj < 2; ++bj) { const int R = rm * 256 + 128 * ai + 64 * wr + 16 * m + fr, n8 = u.pn * 256 + 128 * bj + 32 * wc + 8 * fq; uw[m][bj] = *(const u32x4*)(acat + ((size_t)g * 512 + R) * SKA + n8); }
#pragma unroll
            for (int m = 0; m < 4; ++m) { const int R = rm * 256 + 128 * ai + 64 * wr + 16 * m + fr;
#pragma unroll
                for (int bj = 0; bj < 2; ++bj) {
                    const int n8 = u.pn * 256 + 128 * bj + 32 * wc + 8 * fq; const int t = n8 >> 4, o0 = n8 & 15;
                    const u32x4 w = uw[m][bj]; const f32x4 d0 = dd[bj][0], d1 = dd[bj][1];
                    const f32x4 v0 = acc[ai][bj][m][0], v1 = acc[ai][bj][m][1];
                    float y[8] = {v0[0] + d0[0] * bf_lo(w.x), v0[1] + d0[1] * bf_hi(w.x), v0[2] + d0[2] * bf_lo(w.y), v0[3] + d0[3] * bf_hi(w.y),
                                  v1[0] + d1[0] * bf_lo(w.z), v1[1] + d1[1] * bf_hi(w.z), v1[2] + d1[2] * bf_lo(w.w), v1[3] + d1[3] * bf_hi(w.w)};
#pragma unroll
                    for (int j = 0; j < 8; ++j) y[j] = gelu_tanh_fast(y[j]);
                    *(u32x4*)(gb + ((size_t)R * 32 + t) * D + g * 16 + o0) = (u32x4){cvt_pk_bf16(y[0], y[1]), cvt_pk_bf16(y[2], y[3]), cvt_pk_bf16(y[4], y[5]), cvt_pk_bf16(y[6], y[7])};
                }
            }
        }
    }
};
struct EpiGlu {
    bf16_t* y;
    __device__ __forceinline__ void operator()(const Acc& acc, const Unit& u, int wr, int wc, int fr, int fq) const {
        const int col8 = u.pn * 128 + 32 * wc + 8 * fq;
        EPI_ROWS_BEGIN
            float o[8];
#pragma unroll
            for (int j = 0; j < 4; ++j) { o[j] = acc[ai][0][m][0][j] * fast_sigmoid(acc[ai][1][m][0][j]); o[4 + j] = acc[ai][0][m][1][j] * fast_sigmoid(acc[ai][1][m][1][j]); }
            *(u32x4*)(y + ((size_t)u.pm * 256 + tr) * D + col8) = (u32x4){cvt_pk_bf16(o[0], o[1]), cvt_pk_bf16(o[2], o[3]), cvt_pk_bf16(o[4], o[5]), cvt_pk_bf16(o[6], o[7])};
        EPI_ROWS_END
    }
};
struct SchedMoe {
    pg8::Order o; const bf16_t* A; const bf16_t* W; int lda; int ldb; int nrows_e;
    const LAS int* tile_e; int nt;
    __device__ __forceinline__ int ktiles(const Unit&) const { return nt; }
    __device__ __forceinline__ bool next(int i, Unit& u) const { return o.next(i, u); }
    __device__ __forceinline__ const char* aptr(const Unit& u) const { return (const char*)(A + (size_t)u.pm * 256 * lda); }
    __device__ __forceinline__ const char* bptr(const Unit& u) const { return (const char*)(W + ((size_t)tile_e[u.pm] * nrows_e + (size_t)u.pn * 256) * ldb); }
};
struct EpiBf16Store {
    bf16_t* O; int ldo;
    __device__ __forceinline__ void operator()(const Acc& acc, const Unit& u, int wr, int wc, int fr, int fq) const {
        EPI_ROWS_BEGIN
            const size_t row = (size_t)u.pm * 256 + tr;
#pragma unroll
            for (int bj = 0; bj < 2; ++bj) { const int col8 = u.pn * 256 + 128 * bj + 32 * wc + 8 * fq; const f32x4 v0 = acc[ai][bj][m][0], v1 = acc[ai][bj][m][1];
                *(u32x4*)(O + row * ldo + col8) = (u32x4){cvt_pk_bf16(v0[0], v0[1]), cvt_pk_bf16(v0[2], v0[3]), cvt_pk_bf16(v1[0], v1[1]), cvt_pk_bf16(v1[2], v1[3])}; }
        EPI_ROWS_END
    }
};
struct SchedCtxSplit {
    pg8::Order o; const bf16_t* A; const bf16_t* Bt; int lda, ldb, ntfull, S, G, c;
    __device__ __forceinline__ bool next(int i, Unit& u) const {
        const int L = i * G + c;
        if (L < 256) { o.map(L, u); return true; }
        const int j = L - 256; if (j >= 16 * S) return false;
        const int t = j / S; u.ks = j % S; u.pm = 64 + (t >> 2); u.pn = t & 3; return true; }
    __device__ __forceinline__ int ktiles(const Unit& u) const { return u.ks < 0 ? ntfull : ntfull / S; }
    __device__ __forceinline__ const char* aptr(const Unit& u) const { return (const char*)(A + (size_t)u.pm * 256 * lda + (u.ks < 0 ? 0 : u.ks * (ntfull / S) * 64)); }
    __device__ __forceinline__ const char* bptr(const Unit& u) const { return (const char*)(Bt + (size_t)u.pn * 256 * ldb + (u.ks < 0 ? 0 : u.ks * (ntfull / S) * 64)); }
};
struct EpiBf16OrPart {
    bf16_t* O; int ldo; float* part; int row0, nrows;
    __device__ __forceinline__ void operator()(const Acc& acc, const Unit& u, int wr, int wc, int fr, int fq) const {
        EPI_ROWS_BEGIN
            const size_t row = (size_t)u.pm * 256 + tr;
#pragma unroll
            for (int bj = 0; bj < 2; ++bj) { const int col8 = u.pn * 256 + 128 * bj + 32 * wc + 8 * fq; const f32x4 v0 = acc[ai][bj][m][0], v1 = acc[ai][bj][m][1];
                if (u.ks < 0) *(u32x4*)(O + row * ldo + col8) = (u32x4){cvt_pk_bf16(v0[0], v0[1]), cvt_pk_bf16(v0[2], v0[3]), cvt_pk_bf16(v1[0], v1[1]), cvt_pk_bf16(v1[2], v1[3])};
                else { float* pp = part + ((size_t)u.ks * nrows + (row - row0)) * D + col8; *(f32x4*)pp = v0; *(f32x4*)(pp + 4) = v1; } }
        EPI_ROWS_END
    }
};
struct SchedMoeD {
    pg8::Order o; const bf16_t* A; const bf16_t* W; int lda, ldb, ntfull, S, G, c, RT, NT; const LAS int* tile_e;
    __device__ __forceinline__ bool next(int i, Unit& u) const {
        const int L = i * G + c;
        if (L < RT * 4) { o.map(L, u); return true; }
        const int j = L - RT * 4; if (j >= (NT - RT) * 4 * S) return false;
        const int t = j / S; u.ks = (S > 1) ? j % S : -1; u.pm = RT + (t >> 2); u.pn = t & 3; return true; }
    __device__ __forceinline__ int ktiles(const Unit& u) const { return u.ks < 0 ? ntfull : ntfull / S; }
    __device__ __forceinline__ const char* aptr(const Unit& u) const { return (const char*)(A + (size_t)u.pm * 256 * lda + (u.ks < 0 ? 0 : u.ks * (ntfull / S) * 64)); }
    __device__ __forceinline__ const char* bptr(const Unit& u) const { return (const char*)(W + ((size_t)tile_e[u.pm] * 1024 + (size_t)u.pn * 256) * ldb + (u.ks < 0 ? 0 : u.ks * (ntfull / S) * 64)); }
};
__device__ __forceinline__ void moe_split_plan(int NT, int G, int& RT, int& S) {
    RT = ((NT * 4) / G) * G / 4; const int rem = (NT - RT) * 4; S = (rem > 0 && rem * 7 <= G) ? 7 : ((rem > 0 && rem * 4 <= G) ? 4 : ((rem > 0 && rem * 2 <= G) ? 2 : 1));
    if (RT == 0) { RT = NT; S = 1; }
}
}
namespace fp {
template <int DQK> struct AttnCfg { static constexpr int KP = 2 * DQK + 16, KBYTES = 64 * KP, VBYTES = 8192, BUF = KBYTES + VBYTES, CK = DQK / 8, NKCH = 64 * CK; };
struct AttnArgs {
    const bf16_t* Q; int qp; const bf16_t* K; int kp; const bf16_t* V; int vp; bf16_t* O; int op;
    int qrow0;
    int k0row, nt0;
    int k1row, nt1;
    int gr0, krow0, window;
};
__device__ __forceinline__ int crow(int r, int hi) { return (r & 3) + 8 * (r >> 2) + 4 * hi; }
__device__ __forceinline__ s16x4 ds_tr(LAS const unsigned char* p) { typedef short v4i16_t __attribute__((ext_vector_type(4))); return __builtin_bit_cast(s16x4, __builtin_amdgcn_ds_read_tr16_b64_v4i16((LAS v4i16_t*)p)); }

__device__ __forceinline__ void glds16(const void* gsrc, unsigned lds_dst) { unsigned keep;
    asm volatile("s_mov_b32 %0, m0\n\ts_mov_b32 m0, %2\n\ts_nop 0\n\tglobal_load_lds_dwordx4 %1, off\n\ts_mov_b32 m0, %0" : "=&s"(keep) : "v"(gsrc), "s"(lds_dst) : "memory"); }
__device__ __forceinline__ float max3f(float a, float b, float c) { float r; asm("v_max3_f32 %0, %1, %2, %3" : "=v"(r) : "v"(a), "v"(b), "v"(c)); return r; }
template <int DQK, bool NAW, bool DEFER>
__device__ __forceinline__ void attn_body(LAS unsigned char* lds, const AttnArgs& A, const LAS float* bias) {
    typedef AttnCfg<DQK> C;
    constexpr int VOFF = 2 * C::KBYTES;
    const int tid = threadIdx.x, lane = tid & 63, w = __builtin_amdgcn_readfirstlane(tid >> 6), q = lane & 31, hi = lane >> 5;
    constexpr int ND = DQK / 16;
    bf16x8 qf[ND];
    { const bf16_t* qr = A.Q + (size_t)(A.qrow0 + 32 * w + q) * A.qp + 8 * hi;
#pragma unroll
      for (int d0 = 0; d0 < ND; ++d0) qf[d0] = *(const bf16x8*)(qr + 16 * d0); }
    const int NT = A.nt0 + A.nt1;
    const int kid0 = tid, kid1 = tid + 512; const bool has1 = kid1 < C::NKCH;
    const int kr0 = kid0 / C::CK, kc0 = kid0 % C::CK, kr1 = kid1 / C::CK, kc1 = kid1 % C::CK, vr = tid >> 3, vc = tid & 7;
    const unsigned kl0 = kr0 * C::KP + kc0 * 16, kl1 = kr1 * C::KP + kc1 * 16, vl = VOFF + (vc >> 2) * 4096 + vr * 64 + (vc & 3) * 16;
    u32x4 rk0, rk1, rv; rk1 = (u32x4){0u, 0u, 0u, 0u};
#define ATT_LOAD(t) do { const int rb_ = (t) < A.nt0 ? A.k0row + 64 * (t) : A.k1row + 64 * ((t) - A.nt0); \
        rk0 = *(const u32x4*)(A.K + (size_t)(rb_ + kr0) * A.kp + kc0 * 8); if (has1) rk1 = *(const u32x4*)(A.K + (size_t)(rb_ + kr1) * A.kp + kc1 * 8); \
        rv = *(const u32x4*)(A.V + (size_t)(rb_ + vr) * A.vp + vc * 8); } while (0)
#define ATT_WRITE(kslot, vslot) do { *(LAS u32x4*)(lds + (kslot) * C::KBYTES + kl0) = rk0; if (has1) *(LAS u32x4*)(lds + (kslot) * C::KBYTES + kl1) = rk1; *(LAS u32x4*)(lds + (vslot) * C::VBYTES + vl) = rv; } while (0)
    ATT_LOAD(0);
    __syncthreads();
    ATT_WRITE(0, 0);
    __syncthreads();
    float mrow = 0.f, lrow = 0.f; f32x16 o0 = {}, o1 = {}; f32x16 negm = {}; bool first = true;
    constexpr float THR = 8.f;
    const int gr = A.gr0 + (w >> 1), cq = 32 * (w & 1) + q;
    int rs = gr - 4; rs = rs < 0 ? 0 : (rs > 56 ? 56 : rs); int csq = cq - 8; csq = csq < 0 ? 0 : (csq > 48 ? 48 : csq);
    const int i16 = lane & 15, tq = i16 >> 2, tp = i16 & 3, blk = (lane >> 4) & 1;
    const unsigned voff = VOFF + (4 * hi + tq) * 64 + (16 * blk + 4 * tp) * 2;
    bf16x8 pb[2][2]; bool pend = false; int vs_prev = 0, vs_cur = 0, vs_next = 1;
#define ATT_PV(vslot) do { _Pragma("unroll") for (int kh = 0; kh < 2; ++kh) _Pragma("unroll") for (int s = 0; s < 2; ++s) { \
            LAS const unsigned char* vb = lds + (vslot) * C::VBYTES + voff + (32 * kh + 16 * s) * 64; \
            const s16x4 a0 = ds_tr(vb), a1 = ds_tr(vb + 8 * 64), c0 = ds_tr(vb + 4096), c1 = ds_tr(vb + 4096 + 8 * 64); \
            const bf16x8 va = (bf16x8){a0[0], a0[1], a0[2], a0[3], a1[0], a1[1], a1[2], a1[3]}, vc2 = (bf16x8){c0[0], c0[1], c0[2], c0[3], c1[0], c1[1], c1[2], c1[3]}; \
            o0 = __builtin_amdgcn_mfma_f32_32x32x16_bf16(va, pb[kh][s], o0, 0, 0, 0); \
            o1 = __builtin_amdgcn_mfma_f32_32x32x16_bf16(vc2, pb[kh][s], o1, 0, 0, 0); } } while (0)
    for (int t = 0; t < NT; ++t) {
        const int b = t & 1;
        if (t + 1 < NT) ATT_LOAD(t + 1);
        if (DEFER) { if (pend) { ATT_PV(vs_prev); pend = false; } }
        bool active = true; int krow = 0;
        if (NAW) { if (A.window && t < A.nt0) { krow = A.krow0 + t; active = (krow >= rs) && (krow < rs + 8); } }
        if (active) {
            LAS const unsigned char* kb = lds + b * C::KBYTES;
            f32x16 p0, p1;
#pragma unroll
            for (int d0 = 0; d0 < ND; ++d0) {
                const bf16x8 k0 = *(LAS const bf16x8*)(kb + q * C::KP + (16 * d0 + 8 * hi) * 2);
                const bf16x8 k1 = *(LAS const bf16x8*)(kb + (32 + q) * C::KP + (16 * d0 + 8 * hi) * 2);
                if (d0 == 0) { p0 = __builtin_amdgcn_mfma_f32_32x32x16_bf16(k0, qf[0], negm, 0, 0, 0); p1 = __builtin_amdgcn_mfma_f32_32x32x16_bf16(k1, qf[0], negm, 0, 0, 0); }
                else { p0 = __builtin_amdgcn_mfma_f32_32x32x16_bf16(k0, qf[d0], p0, 0, 0, 0); p1 = __builtin_amdgcn_mfma_f32_32x32x16_bf16(k1, qf[d0], p1, 0, 0, 0); }
            }
            asm volatile("s_nop 15\n\ts_nop 3" : "+v"(p0), "+v"(p1));
            if (NAW) { if (A.window && t < A.nt0) {
                const LAS float* brow = bias + (krow - gr + 7) * 31;
#pragma unroll
                for (int r = 0; r < 16; ++r) { const int ck0 = crow(r, hi), ck1 = 32 + ck0;
                    { const int dc = ck0 - csq; int bi = ck0 - cq + 15; bi = bi < 0 ? 0 : (bi > 30 ? 30 : bi); p0[r] = ((unsigned)dc < 16u) ? p0[r] + brow[bi] : -INFINITY; }
                    { const int dc = ck1 - csq; int bi = ck1 - cq + 15; bi = bi < 0 ? 0 : (bi > 30 ? 30 : bi); p1[r] = ((unsigned)dc < 16u) ? p1[r] + brow[bi] : -INFINITY; } }
            } }
            float ra = max3f(p0[0], p0[1], p1[0]), rb2 = max3f(p0[2], p0[3], p1[1]); ra = max3f(ra, p1[2], p1[3]);
#pragma unroll
            for (int r = 4; r < 16; r += 4) { ra = max3f(ra, p0[r], p0[r + 1]); rb2 = max3f(rb2, p0[r + 2], p0[r + 3]); ra = max3f(ra, p1[r], p1[r + 1]); rb2 = max3f(rb2, p1[r + 2], p1[r + 3]); }
            float rm = max3f(ra, rb2, rb2);
            { auto rr = __builtin_amdgcn_permlane32_swap(__float_as_uint(rm), __float_as_uint(rm), false, false); rm = max3f(__uint_as_float(rr[0]), __uint_as_float(rr[1]), __uint_as_float(rr[1])); }
            if (first || __any(rm > THR)) {
                const float delta = first ? rm : fmaxf(rm, 0.f), alpha = first ? 0.f : __builtin_amdgcn_exp2f(-delta);
                mrow += delta; lrow *= alpha;
#pragma unroll
                for (int r = 0; r < 16; ++r) { p0[r] -= delta; p1[r] -= delta; o0[r] *= alpha; o1[r] *= alpha; negm[r] = -mrow; }
                first = false;
            }
            float ls = 0.f;
#pragma unroll
            for (int r = 0; r < 16; ++r) { p0[r] = __builtin_amdgcn_exp2f(p0[r]); p1[r] = __builtin_amdgcn_exp2f(p1[r]); ls += p0[r] + p1[r]; }
            lrow += ls;
#pragma unroll
            for (int s = 0; s < 2; ++s) {
                pb[0][s] = __builtin_bit_cast(bf16x8, (u32x4){cvt_pk_bf16(p0[8 * s], p0[8 * s + 1]), cvt_pk_bf16(p0[8 * s + 2], p0[8 * s + 3]), cvt_pk_bf16(p0[8 * s + 4], p0[8 * s + 5]), cvt_pk_bf16(p0[8 * s + 6], p0[8 * s + 7])});
                pb[1][s] = __builtin_bit_cast(bf16x8, (u32x4){cvt_pk_bf16(p1[8 * s], p1[8 * s + 1]), cvt_pk_bf16(p1[8 * s + 2], p1[8 * s + 3]), cvt_pk_bf16(p1[8 * s + 4], p1[8 * s + 5]), cvt_pk_bf16(p1[8 * s + 6], p1[8 * s + 7])});
            }
            if (DEFER) pend = true; else ATT_PV(vs_cur);
        }
        if (t + 1 < NT) ATT_WRITE(b ^ 1, vs_next);
        __syncthreads();
        vs_prev = vs_cur; vs_cur = vs_next; vs_next = (vs_next == 2) ? 0 : vs_next + 1;
    }
    if (DEFER) { if (pend) ATT_PV(vs_prev); }
#undef ATT_PV
#undef ATT_LOAD
#undef ATT_WRITE
    { auto rr = __builtin_amdgcn_permlane32_swap(__float_as_uint(lrow), __float_as_uint(lrow), false, false); lrow = __uint_as_float(rr[0]) + __uint_as_float(rr[1]); }
    const float inv = 1.f / lrow;
    bf16_t* orow = A.O + (size_t)(A.qrow0 + 32 * w + q) * A.op;
#pragma unroll
    for (int rg = 0; rg < 4; ++rg) {
        *(u32x2*)(orow + 8 * rg + 4 * hi) = (u32x2){cvt_pk_bf16(o0[4 * rg] * inv, o0[4 * rg + 1] * inv), cvt_pk_bf16(o0[4 * rg + 2] * inv, o0[4 * rg + 3] * inv)};
        *(u32x2*)(orow + 32 + 8 * rg + 4 * hi) = (u32x2){cvt_pk_bf16(o1[4 * rg] * inv, o1[4 * rg + 1] * inv), cvt_pk_bf16(o1[4 * rg + 2] * inv, o1[4 * rg + 3] * inv)};
    }
}
template <int DQK, bool NAW>
__device__ __forceinline__ void attn_unit(LAS unsigned char* lds, const AttnArgs& A, const LAS float* bias) {
    if (__builtin_amdgcn_readfirstlane(threadIdx.x >> 8) == 0) attn_body<DQK, NAW, false>(lds, A, bias); else attn_body<DQK, NAW, true>(lds, A, bias);
}

__device__ __forceinline__ void p4_attention(Frame& F) {
    unsigned char* ws = F.ws; const Args& a = *F.a;
    const bf16_t* P = (const bf16_t*)(ws + WS_P); const bf16_t* Qb = (const bf16_t*)(ws + WS_Q); const bf16_t* Kf = (const bf16_t*)(ws + WS_KF); const bf16_t* Vb = (const bf16_t*)(ws + WS_V); bf16_t* AO = (bf16_t*)(ws + WS_AO);
#ifndef PROBE_PH
#define PROBE_PH -1
#endif
    for (int ii = 0; ii < ((PROBE_PH == 40) ? 5 : 3); ++ii) { const int i = (PROBE_PH == 40 && ii >= 3) ? ii - 3 : ii;
        AttnArgs A; A.gr0 = 0; A.krow0 = 0; A.window = 0;
        if (i < 2) { const int u = F.vcu * 2 + i; if (u >= 512) break; const int bh = u >> 4, qb = u & 15, b = bh >> 3, h = bh & 7;
            A.Q = Qb + h * 96; A.qp = 768; A.K = Kf + h * 96; A.kp = 768; A.V = Vb + h * 64; A.vp = 512; A.O = AO + h * 64; A.op = D;
            A.qrow0 = b * SEQ + qb * 256; A.k0row = b * SEQ; A.nt0 = SEQ / 64; A.k1row = ML + b * CTX; A.nt1 = CTX / 64; }
        else { if (F.vcu >= 32) break; const int b = F.vcu >> 3, h = F.vcu & 7;
            A.Q = Qb + h * 96; A.qp = 768; A.K = Kf + h * 96; A.kp = 768; A.V = Vb + h * 64; A.vp = 512; A.O = AO + h * 64; A.op = D;
            A.qrow0 = ML + b * CTX; A.k0row = ML + b * CTX; A.nt0 = CTX / 64; A.k1row = 0; A.nt1 = 0; }
        attn_unit<96, false>(F.lds, A, nullptr);
    }
    LAS float* bias = (LAS float*)(F.lds + LDS_BIAS);
    for (int ii = 0; ii < ((PROBE_PH == 41) ? 5 : 3); ++ii) { const int i = (PROBE_PH == 41 && ii >= 3) ? ii - 3 : ii;
        AttnArgs A; int h;
        if (i < 2) { const int u = F.vcu * 2 + i; if (u >= 512) break; const int bh = u >> 4, qb = u & 15, b = bh >> 3; h = bh & 7;
            const int gr0 = 4 * qb; int r0 = gr0 - 4; r0 = r0 < 0 ? 0 : (r0 > 56 ? 56 : r0); int r1 = gr0 + 3 - 4; r1 = r1 < 0 ? 0 : (r1 > 56 ? 56 : r1);
            A.qrow0 = b * SEQ + qb * 256; A.k0row = b * SEQ + r0 * 64; A.nt0 = r1 + 8 - r0; A.k1row = ML + b * CTX; A.nt1 = CTX / 64; A.gr0 = gr0; A.krow0 = r0; A.window = 1; }
        else { if (F.vcu < 32 || F.vcu >= 64) break; const int v = F.vcu - 32, b = v >> 3; h = v & 7;
            A.qrow0 = ML + b * CTX; A.k0row = ML + b * CTX; A.nt0 = CTX / 64; A.k1row = 0; A.nt1 = 0; A.gr0 = 0; A.krow0 = 0; A.window = 0; }
        A.Q = P + 672 + h * 64; A.qp = NIN; A.K = P + 1184 + h * 64; A.kp = NIN; A.V = P + 1696 + h * 64; A.vp = NIN; A.O = AO + 512 + h * 64; A.op = D;
        __syncthreads();
        if (F.tid < 465) bias[F.tid] = a.in[I_rpb][h * 465 + F.tid] * LOG2E;
        attn_unit<64, true>(F.lds, A, bias);
    }
}

__device__ __forceinline__ void p12_scan(Frame& F) {
    unsigned char* ws = F.ws; const Args& a = *F.a;
    const float* sloc = (const float*)(ws + WS_SLOC); bf16_t* acat = (bf16_t*)(ws + WS_ACAT);
    const int gwv = F.vcu * NWAVES + F.wave;
    if (gwv >= NB * 64 * 2) return;
    const int dir = gwv & 1, g = (gwv >> 1) & 63, b = gwv >> 7, p = F.lane;
    const f32x4 dsc = s5_disc(a, g, dir, p); const f32x2 aT = cpow(dsc.x, dsc.y, (float)TCH);
    float sr = 0.f, si = 0.f;
    const float* base = sloc + (size_t)g * 544 * 256 + dir * 128 + p;
    bf16_t* abase = acat + (size_t)g * 512 * SKA + SK + dir * 128 + p;
    {
        float lr[8], li[8];
#pragma unroll
        for (int j = 0; j < 8; ++j) { const int c = dir ? NCHC - 1 - j : j; const size_t R = 512 + b * NCHC + c; lr[j] = base[R * 256]; li[j] = base[R * 256 + 64]; }
#pragma unroll
        for (int j = 0; j < 8; ++j) { const float nr = aT.x * sr - aT.y * si + lr[j], ni = aT.x * si + aT.y * sr + li[j]; sr = nr; si = ni; }
    }
    for (int s0 = 0; s0 < NCH; s0 += 16) {
        float lr[16], li[16];
#pragma unroll
        for (int j = 0; j < 16; ++j) { const int c = dir ? NCH - 1 - (s0 + j) : s0 + j; const size_t R = b * NCH + c; lr[j] = base[R * 256]; li[j] = base[R * 256 + 64]; }
#pragma unroll
        for (int j = 0; j < 16; ++j) { const int c = dir ? NCH - 1 - (s0 + j) : s0 + j; const size_t R = b * NCH + c;
            bf16_t* ap = abase + R * SKA; ap[0] = (bf16_t)f2bf(sr); ap[64] = (bf16_t)f2bf(si);
            const float nr = aT.x * sr - aT.y * si + lr[j], ni = aT.x * si + aT.y * sr + li[j]; sr = nr; si = ni; }
    }
}

__device__ __forceinline__ void moe_tables(Frame& F) {
    LAS int* toff = (LAS int*)(F.lds + LDS_MOE); LAS int* te = toff + 16;
    __syncthreads();
    if (F.tid == 0) { const unsigned* cnt = (const unsigned*)(F.ws + WS_CTL + CTL_CNT); int acc = 0;
        for (int e = 0; e < NE; ++e) { toff[e] = acc; const int n = (int)((__hip_atomic_load(cnt + 64 * e, __ATOMIC_RELAXED, __HIP_MEMORY_SCOPE_AGENT) + 255u) >> 8); for (int j = 0; j < n; ++j) te[acc + j] = e; acc += n; }
        toff[NE] = acc; }
    __syncthreads();
}
#ifndef TSTAMP
#define TSTAMP -1
#endif
#ifndef TSPAN
#define TSPAN 1
#endif
#define FSTAMP(F, k) do { if (TSTAMP >= 0 && blockIdx.x == 0 && (F).tid == 0) { volatile LAS unsigned long long* tsl_ = (volatile LAS unsigned long long*)((F).lds + LDS_MISC + 128); if ((k) == TSTAMP) tsl_[0] = wall_clock64(); if ((k) == TSTAMP + TSPAN) tsl_[1] = wall_clock64(); } } while (0)
__device__ __forceinline__ void p15_route_gather(Frame& F) {
    unsigned char* ws = F.ws; const Args& a = *F.a; const int lane = F.lane;
    const float* mp1 = (const float*)(ws + WS_MODP) + 5 * 6144;
    LAS int* lcnt = (LAS int*)(F.lds + LDS_BIAS);
    LAS int* lrec = lcnt + 16;
    LAS float* lw = (LAS float*)(lrec + 256);
    LAS int* toff = (LAS int*)(F.lds + LDS_MOE); LAS int* te = toff + 16;
    if (F.tid < 16) lcnt[F.tid] = 0;
    __syncthreads();
    int* tok_r = (int*)(ws + WS_TOK); float* tok_w = (float*)(ws + WS_TOK + (size_t)ML * 8);
    f32x4 rw0[16], rw1[16];
#pragma unroll
    for (int j = 0; j < 4; ++j)
#pragma unroll
        for (int c = 0; c < 4; ++c) { const int k = 4 * (lane + 64 * j) + c; rw0[4 * j + c] = *(const f32x4*)(a.in[I_router] + (size_t)k * 8); rw1[4 * j + c] = *(const f32x4*)(a.in[I_router] + (size_t)k * 8 + 4); }
    LAS float* tabm = (LAS float*)(F.lds + LDS_MODT); const int row_base = F.vcu * 64 + F.wave * 8;
    load_modtab(F, tabm, (F.vcu * 64) / SEQ, 1, mp1 + 2 * 1024, mp1 + 3 * 1024, mp1 + 4 * 1024, a.in[I_n2g] + D);
    for (int ib = 0; ib < 4; ++ib) {
        const float* xr[2]; bf16_t* orow[2]; f32x4 v[2][4]; int rows[2]; const bf16_t* yr[2]; const LAS float* tb[2]; float* xo[2]; LAS u32x2* lrow[2];
#pragma unroll
        for (int r = 0; r < 2; ++r) { const int row = row_base + 2 * ib + r; const bool ok = row < ML; const int rw = ok ? row : 0; rows[r] = ok ? row : -1;
            xr[r] = ok ? (const float*)((const bf16_t*)(ws + WS_XB) + (size_t)rw * D) : nullptr; orow[r] = nullptr; tb[r] = tabm;
            yr[r] = (const bf16_t*)(ws + WS_Y3) + (size_t)rw * D; xo[r] = a.out + (size_t)rw * D; lrow[r] = (LAS u32x2*)(F.lds + (F.wave * 8 + 2 * ib + r) * 2048); }
        modulate_rows<2, true, true, true>(xr, yr, tb, xo, orow, lane, v, lrow);
#pragma unroll
        for (int r = 0; r < 2; ++r) if (rows[r] >= 0) {
            float lg[8] = {0.f, 0.f, 0.f, 0.f, 0.f, 0.f, 0.f, 0.f};
#pragma unroll
            for (int j = 0; j < 4; ++j)
#pragma unroll
                for (int c = 0; c < 4; ++c) { const f32x4 w0 = rw0[4 * j + c], w1 = rw1[4 * j + c]; const float tv = v[r][j][c];
                    lg[0] += tv * w0[0]; lg[1] += tv * w0[1]; lg[2] += tv * w0[2]; lg[3] += tv * w0[3]; lg[4] += tv * w1[0]; lg[5] += tv * w1[1]; lg[6] += tv * w1[2]; lg[7] += tv * w1[3]; }
#pragma unroll
            for (int e = 0; e < 8; ++e) lg[e] = wave_sum(lg[e]);
            if (lane == 0) {
                int i1 = 0; for (int e = 1; e < 8; ++e) if (lg[e] > lg[i1]) i1 = e;
                int i2 = -1; for (int e = 0; e < 8; ++e) if (e != i1 && (i2 < 0 || lg[e] > lg[i2])) i2 = e;
                const float e2 = expf(lg[i2] - lg[i1]), w1 = 1.f / (1.f + e2), w2 = e2 / (1.f + e2);
                const int li = F.wave * 8 + 2 * ib + r;
                lrec[li * 4 + 0] = i1; lrec[li * 4 + 1] = i2;
                lw[li * 2] = w1; lw[li * 2 + 1] = w2;
            }
        }
    }
    FSTAMP(F, 100);
    __syncthreads();
    if (F.wave < 2) { const int idx = F.wave * 64 + lane, li = idx >> 1, k = idx & 1; const int e = lrec[li * 4 + k]; int rank = 0;
#pragma unroll
        for (int ee = 0; ee < 8; ++ee) { const unsigned long long m = __ballot(e == ee); if (e == ee) rank = __popcll(m & ((1ull << lane) - 1ull)); if (lane == 0) lcnt[16 * 0 + (F.wave ? 8 : 0) + ee] = __popcll(m); }
        lrec[li * 4 + 2 + k] = rank; }
    __syncthreads();
    if (F.wave == 1) { const int idx = 64 + lane, li = idx >> 1, k = idx & 1; lrec[li * 4 + 2 + k] += lcnt[lrec[li * 4 + k]]; }
    __syncthreads();
    unsigned* cnt = (unsigned*)(ws + WS_CTL + CTL_CNT); unsigned* done = (unsigned*)(ws + WS_CTL + CTL_DONE); unsigned* btab = (unsigned*)(ws + WS_CTL + CTL_BTAB);
    if (F.tid < 8) { const unsigned n = (unsigned)(lcnt[F.tid] + lcnt[8 + F.tid]); (void)__hip_atomic_fetch_add(cnt + 64 * F.tid, n, __ATOMIC_RELAXED, __HIP_MEMORY_SCOPE_AGENT); __hip_atomic_store(btab + blockIdx.x * 8 + F.tid, n, __ATOMIC_RELAXED, __HIP_MEMORY_SCOPE_AGENT); }
    asm volatile("s_waitcnt vmcnt(0)" ::: "memory");
    __syncthreads();
    if (F.tid == 0) {
        __builtin_amdgcn_fence(__ATOMIC_RELEASE, "agent"); asm volatile("s_waitcnt vmcnt(0)" ::: "memory");
        (void)__hip_atomic_fetch_add(done, 1u, __ATOMIC_RELAXED, __HIP_MEMORY_SCOPE_AGENT);
        unsigned sp = 0; while (__hip_atomic_load(done, __ATOMIC_RELAXED, __HIP_MEMORY_SCOPE_AGENT) < (unsigned)F.G) { __builtin_amdgcn_s_sleep(2); if (++sp > (1u << 20)) break; }
        __builtin_amdgcn_fence(__ATOMIC_ACQUIRE, "agent");
        int acc = 0;
        for (int e = 0; e < NE; ++e) { toff[e] = acc; const int n = (int)((__hip_atomic_load(cnt + 64 * e, __ATOMIC_RELAXED, __HIP_MEMORY_SCOPE_AGENT) + 255u) >> 8); for (int j = 0; j < n; ++j) te[acc + j] = e; acc += n; }
        toff[NE] = acc;
    }
    if (F.tid < 8) lcnt[8 + F.tid] = 0;
    __syncthreads();
    if (F.wave < 4) {
        const int b = F.wave * 64 + lane; unsigned c[8];
#pragma unroll
        for (int e = 0; e < 8; ++e) c[e] = (b < (int)blockIdx.x && b < F.G) ? __hip_atomic_load(btab + b * 8 + e, __ATOMIC_RELAXED, __HIP_MEMORY_SCOPE_AGENT) : 0u;
#pragma unroll
        for (int e = 0; e < 8; ++e) { const int sm = (int)wave_sum((float)c[e]); if (lane == 0 && sm) (void)__hip_atomic_fetch_add(lcnt + 8 + e, sm, __ATOMIC_RELAXED, __HIP_MEMORY_SCOPE_WORKGROUP); }
    }
    __syncthreads();
    FSTAMP(F, 101);
    bf16_t* Xg = (bf16_t*)(ws + WS_XG);
    for (int i = 0; i < 8; ++i) { const int li = F.wave * 8 + i; const int row = row_base + i; if (row >= ML) continue;
        const int e0 = lrec[li * 4], e1 = lrec[li * 4 + 1]; const size_t r0 = (size_t)toff[e0] * 256 + lcnt[8 + e0] + lrec[li * 4 + 2], r1 = (size_t)toff[e1] * 256 + lcnt[8 + e1] + lrec[li * 4 + 3];
        const LAS u32x4* src = (const LAS u32x4*)(F.lds + li * 2048); const u32x4 x0 = src[lane], x1 = src[lane + 64];
        u32x4* d0 = (u32x4*)(Xg + r0 * D); u32x4* d1 = (u32x4*)(Xg + r1 * D); d0[lane] = x0; d0[lane + 64] = x1; d1[lane] = x0; d1[lane + 64] = x1;
        if (lane == 0) { tok_r[row * 2] = (int)r0; tok_r[row * 2 + 1] = (int)r1; tok_w[row * 2] = lw[li * 2]; tok_w[row * 2 + 1] = lw[li * 2 + 1]; } }
    __syncthreads();
}
__device__ __forceinline__ void p19_final(Frame& F) {
    unsigned char* ws = F.ws; const Args& a = *F.a; const LAS int* toff = (const LAS int*)(F.lds + LDS_MOE); const int lane = (int)__builtin_amdgcn_mbcnt_hi(~0u, __builtin_amdgcn_mbcnt_lo(~0u, 0u));
    const int* tok_r = (const int*)(ws + WS_TOK); const float* tok_w = (const float*)(ws + WS_TOK + (size_t)ML * 8);
    const bf16_t* Yg = (const bf16_t*)(ws + WS_XG); const float* mp1 = (const float*)(ws + WS_MODP) + 5 * 6144;
    const int NGW = F.G * NWAVES; int RT, SS; moe_split_plan(toff[NE], F.G, RT, SS); const size_t prow0 = (size_t)RT * 256, pn = (size_t)(toff[NE] - RT) * 256;
    const float* part = (const float*)(ws + WS_PART18);
#ifndef TSTAMP
#define TSTAMP -1
#endif
#ifndef CK_PH
#define CK_PH -1
#endif
    const float tscale = (CK_PH >= 0) ? 1.f + 0.02f * (float)(__hip_atomic_load((const unsigned*)(ws + WS_CTL + CTL_TS + 128), __ATOMIC_RELAXED, __HIP_MEMORY_SCOPE_AGENT) & 63u) : (TSTAMP >= 0) ? ((const float*)(ws + WS_CTL + CTL_TS))[0] : 1.f;
    LAS float* tab = (LAS float*)F.lds;
    load_modtab(F, tab, 0, NB, mp1 + 5 * 1024, nullptr, nullptr, a.in[I_fing]);
    for (int row0 = F.vcu * NWAVES + F.wave; row0 < ML; row0 += 2 * NGW) {
        f32x4 v[2][4], ya[2][4], yb[2][4]; float w0[2], w1[2]; bool ok[2];
#pragma unroll
        for (int r = 0; r < 2; ++r) { const int row = row0 + r * NGW; ok[r] = row < ML; if (ok[r]) {
            const size_t ra = (size_t)tok_r[row * 2], rb = (size_t)tok_r[row * 2 + 1]; w0[r] = tok_w[row * 2]; w1[r] = tok_w[row * 2 + 1];
#pragma unroll
            for (int j = 0; j < 4; ++j) v[r][j] = ((const f32x4*)(a.out + (size_t)row * D))[lane + 64 * j];
            if (SS > 1 && ra >= prow0) {
#pragma unroll
                for (int j = 0; j < 4; ++j) ya[r][j] = (f32x4){0.f, 0.f, 0.f, 0.f};
                for (int s = 0; s < SS; ++s) { const f32x4* pp = (const f32x4*)(part + ((size_t)s * pn + (ra - prow0)) * D);
#pragma unroll
                    for (int j = 0; j < 4; ++j) ya[r][j] += pp[lane + 64 * j]; }
#pragma unroll
                for (int j = 0; j < 4; ++j) { const unsigned lo = cvt_pk_bf16(ya[r][j].x, ya[r][j].y), hi2 = cvt_pk_bf16(ya[r][j].z, ya[r][j].w); ya[r][j] = (f32x4){bf_lo(lo), bf_hi(lo), bf_lo(hi2), bf_hi(hi2)}; }
            } else {
#pragma unroll
                for (int j = 0; j < 4; ++j) { const u32x2 y = *((const u32x2*)(Yg + ra * D) + lane + 64 * j); ya[r][j] = (f32x4){bf_lo(y.x), bf_hi(y.x), bf_lo(y.y), bf_hi(y.y)}; } }
            if (SS > 1 && rb >= prow0) {
#pragma unroll
                for (int j = 0; j < 4; ++j) yb[r][j] = (f32x4){0.f, 0.f, 0.f, 0.f};
                for (int s = 0; s < SS; ++s) { const f32x4* pp = (const f32x4*)(part + ((size_t)s * pn + (rb - prow0)) * D);
#pragma unroll
                    for (int j = 0; j < 4; ++j) yb[r][j] += pp[lane + 64 * j]; }
#pragma unroll
                for (int j = 0; j < 4; ++j) { const unsigned lo = cvt_pk_bf16(yb[r][j].x, yb[r][j].y), hi2 = cvt_pk_bf16(yb[r][j].z, yb[r][j].w); yb[r][j] = (f32x4){bf_lo(lo), bf_hi(lo), bf_lo(hi2), bf_hi(hi2)}; }
            } else {
#pragma unroll
                for (int j = 0; j < 4; ++j) { const u32x2 y = *((const u32x2*)(Yg + rb * D) + lane + 64 * j); yb[r][j] = (f32x4){bf_lo(y.x), bf_hi(y.x), bf_lo(y.y), bf_hi(y.y)}; } }
        } }
#pragma unroll
        for (int r = 0; r < 2; ++r) if (ok[r]) { const int row = row0 + r * NGW; const LAS float* tb = tab + (size_t)(row / SEQ) * 3072; float* xr = a.out + (size_t)row * D; float ss = 0.f;
#pragma unroll
            for (int j = 0; j < 4; ++j) { const int c4 = lane + 64 * j; const f32x4 gg = ((const LAS f32x4*)tb)[c4];
                v[r][j] = v[r][j] + gg * (w0[r] * ya[r][j] + w1[r] * yb[r][j]); ss += (v[r][j].x * v[r][j].x + v[r][j].y * v[r][j].y) + (v[r][j].z * v[r][j].z + v[r][j].w * v[r][j].w); }
            const float rs = rsqrtf(wave_sum(ss) * (1.f / D) + EPS);
#pragma unroll
            for (int j = 0; j < 4; ++j) { const int c4 = lane + 64 * j; ((f32x4*)xr)[c4] = v[r][j] * (rs * tscale) * ((const LAS f32x4*)(tb + 2048))[c4]; } }
    }
}
}
namespace fp {
constexpr int NPH = 20;
#ifndef ALIGN17
#define ALIGN17 true
#endif
constexpr int CW_BAR = 4096;
#ifndef TC_Q2
#define TC_Q2 8
#endif
#ifndef TC_Q5
#define TC_Q5 0
#endif
#ifndef TC_Q8
#define TC_Q8 0
#endif
#ifndef TC_Q10
#define TC_Q10 6
#endif
#ifndef TC_Q11
#define TC_Q11 6
#endif
constexpr int TCA = TC_P0, TCB = TCA + 156 * TC_Q2  , TCC = TCB + 240 * TC_Q5  , TCD = TCC + 240 * TC_Q8  , TCE = TCD + 240 * TC_Q10  , TCF = TCE + 64 * TC_Q11  ;

__global__ void __launch_bounds__(NTHR, 2) fwd(Args args) {
    extern __shared__ __attribute__((aligned(16))) unsigned char lds_raw[];
    Frame F;
    F.lds = (LAS unsigned char*)lds_raw; F.tid = threadIdx.x; F.lane = F.tid & 63; F.wave = __builtin_amdgcn_readfirstlane(F.tid >> 6);
    F.G = gridDim.x; { const int bx = blockIdx.x; F.vcu = (F.G % 8 == 0) ? (bx % 8) * (F.G / 8) + bx / 8 : bx; }
    F.a = &args; F.ws = args.ws; F.tailconv = (gridDim.x == 256 && args.ph_lo == 0 && args.ph_hi == NPH) ? 1 : 0;
    unsigned char* ws = args.ws;
    volatile LAS unsigned* MISC = (volatile LAS unsigned*)(F.lds + LDS_MISC);
    if (F.tid < 64) MISC[F.tid] = 0u;
    { LAS f32x2* rope = (LAS f32x2*)(F.lds + LDS_ROPE); const int pos = F.tid >> 3, f = F.tid & 7; const float inv = powf(10000.f, -(float)f * 0.125f), ang = (float)pos * inv; rope[F.tid] = (f32x2){cosf(ang), sinf(ang)}; }
    __syncthreads();
    const int lo = args.ph_lo, hi = args.ph_hi;
    const bool multi = (hi - lo) > 1;
    XcdBarrier bar; bar.bar = (unsigned*)(ws + WS_CTL) + CW_BAR; bar.x = 0; bar.st = MISC;
    if (multi) bar = xcd_barrier_post((unsigned*)(ws + WS_CTL) + CW_BAR, MISC);
#ifndef PH_MASK
#define PH_MASK 0xFFFFF
#endif
#define IN(k) ((((PH_MASK) >> (k)) & 1) && lo <= (k) && (k) < hi)
#ifndef TSTAMP
#define TSTAMP -1
#endif
    volatile LAS unsigned long long* tsl = (volatile LAS unsigned long long*)(F.lds + LDS_MISC + 128);
#define STAMP(k) do { if (TSTAMP >= 0 && blockIdx.x == 0 && F.tid == 0) { if ((k) == TSTAMP) tsl[0] = wall_clock64(); if ((k) == TSTAMP + TSPAN) tsl[1] = wall_clock64(); } } while (0)
#ifndef TSPAN
#define TSPAN 1
#endif
#ifndef TSDIV
#define TSDIV 4000
#endif
#ifndef TSBIAS
#define TSBIAS 0
#endif
#ifndef PROBE_PH
#define PROBE_PH -1
#endif
#define RPT(k) for (int rep_ = 0; rep_ < ((PROBE_PH == (k)) ? 2 : 1); ++rep_)
#ifndef CK_PH
#define CK_PH -1
#endif
#ifndef CK_OFF
#define CK_OFF 0
#define CK_BYTES 0
#endif
#ifndef CK_PITCH
#define CK_PITCH 4096
#define CK_C0 0
#define CK_C1 4096
#endif
#define CKSUM(k) do { if (CK_PH == (k)) { xcd_barrier(bar); const unsigned* cp_ = (const unsigned*)(ws + (size_t)CK_OFF); const size_t nw_ = (size_t)CK_BYTES / 4; unsigned sm_ = 0u; \
        for (size_t i_ = (size_t)blockIdx.x * NTHR + F.tid; i_ < nw_; i_ += (size_t)F.G * NTHR) { const unsigned w_ = __hip_atomic_load(cp_ + i_, __ATOMIC_RELAXED, __HIP_MEMORY_SCOPE_AGENT); const unsigned ob_ = (unsigned)((i_ * 4) % (size_t)CK_PITCH); if (ob_ >= (unsigned)CK_C0 && ob_ < (unsigned)CK_C1) sm_ += w_ * 2654435761u + (w_ >> 7); } \
        atomicAdd((unsigned*)(ws + WS_CTL + CTL_TS + 128), sm_); } } while (0)
#define SEAM(k) do { CKSUM(k); if (IN(k) && IN((k) + 1)) xcd_barrier(bar); } while (0)
    const LAS f32x2* rope = (const LAS f32x2*)(F.lds + LDS_ROPE);
    float* modp = (float*)(ws + WS_MODP);
    bf16_t* HB = (bf16_t*)(ws + WS_HB);
    float* XC = (float*)(ws + WS_XC);
    bf16_t* XB = (bf16_t*)(ws + WS_XB);

    F.wait_adaln = (IN(0) && IN(1)) ? 1 : 0;
    STAMP(0); GSTAMP(F, -1);
    if (IN(0)) RPT(0) { p0_prologue(F, rep_); }
    if (IN(0) && IN(1)) { if (!F.tailconv) xcd_barrier(bar); else __syncthreads(); }
    STAMP(1);
    if (IN(1)) RPT(1) { p1_phase(F); } GSTAMP(F, 2); SEAM(1); GSTAMP(F, 3);
    STAMP(2);
    if (IN(2)) { constexpr int REP_ = (PROBE_PH == 2) ? 2 : 1;
        SchedPlain S; S.o.init(MT / 256, NIN / 256, F.G, (int)blockIdx.x, REP_); S.A = HB; S.Bt = (const bf16_t*)(ws + WS_WIN0); S.lda = D; S.ldb = D; S.nt = D / 64;
        EpiInProj E{(bf16_t*)(ws + WS_P), (float*)(ws + WS_SSQ), (bf16_t*)(ws + WS_KF), rope};
        pg8::gemm_phase<EpiInProj, SchedPlain>(F.lds, D, D, D, S, E);
        if (F.tailconv && (int)blockIdx.x >= 100 && REP_ == 1) tail_convert(F, TCA, TCB, (int)blockIdx.x - 100, 156);
    } SEAM(2);
    STAMP(3);
    if (IN(3)) { constexpr int REP_ = (PROBE_PH == 3) ? 2 : 1;
#ifndef NO_QB
        { SchedPlain S; S.o.init(MT / 256, 768 / 256, F.G, (int)blockIdx.x, REP_); S.A = (const bf16_t*)(ws + WS_P); S.Bt = (const bf16_t*)(ws + WS_WQB); S.lda = NIN; S.ldb = 384; S.nt = 384 / 64;
          EpiQb E{(bf16_t*)(ws + WS_Q), (const float*)(ws + WS_SSQ), rope};
          pg8::gemm_phase<EpiQb, SchedPlain>(F.lds, 384, NIN, 384, S, E); }
#endif
#ifndef NO_KVB
        { SchedPlain S; S.o.init(MT / 256, 1024 / 256, F.G, (int)blockIdx.x, REP_); S.A = (const bf16_t*)(ws + WS_P) + 384; S.Bt = (const bf16_t*)(ws + WS_WKVB); S.lda = NIN; S.ldb = 256; S.nt = 256 / 64;
          EpiKvb E{(bf16_t*)(ws + WS_KF), (bf16_t*)(ws + WS_V), (const float*)(ws + WS_SSQ)};
          pg8::gemm_phase<EpiKvb, SchedPlain>(F.lds, 256, NIN, 256, S, E); }
#endif
    } SEAM(3);
    STAMP(4);
    if (IN(4)) RPT(4) { p4_attention(F); } GSTAMP(F, 10); SEAM(4);
    STAMP(5);
    if (IN(5)) { constexpr int REP_ = 1;
        SchedCtxSplit S; S.o.init(64, 4, F.G, (int)blockIdx.x, 1); S.A = (const bf16_t*)(ws + WS_AO); S.Bt = (const bf16_t*)(ws + WS_WOUT); S.lda = D; S.ldb = D; S.ntfull = D / 64; S.S = 4; S.G = F.G; S.c = (int)blockIdx.x;
        EpiBf16OrPart E{(bf16_t*)(ws + WS_Y1), D, (float*)(ws + WS_PART5), ML, MC};
        pg8::gemm_phase<EpiBf16OrPart, SchedCtxSplit>(F.lds, D, D, D, S, E); (void)REP_;
    } SEAM(5);
    STAMP(6);
    if (IN(6)) RPT(6) {
        const int NGW = F.G * NWAVES; const bf16_t* Y1 = (const bf16_t*)(ws + WS_Y1);
        LAS float* tab = (LAS float*)F.lds;
        load_modtab(F, tab, 0, NB + 1, modp + 2 * 1024, modp + 3 * 1024, modp + 4 * 1024, args.in[I_n2g]);
        { const int r = F.vcu * NWAVES + F.wave; if (r < MC)
            ctx_row_part(args.in[I_ctx] + (size_t)r * D, XC + (size_t)r * D, (const float*)(ws + WS_PART5), 4, r, tab + (size_t)NB * 3072, HB + (size_t)(ML + r) * D, F.lane); }
        { const int gw = F.vcu * NWAVES + F.wave; RowRegs A0, A1, B0, B1;
#define P6_LOAD(R, k) load_row<true>(R, args.in[I_x] + (size_t)(gw + (k) * NGW) * D, Y1 + (size_t)(gw + (k) * NGW) * D, F.lane)
#define P6_FIN(R, k) do { const int rw_ = gw + (k) * NGW; finish_row<true, false, true>(R, tab + (size_t)(rw_ / SEQ) * 3072, XB + (size_t)rw_ * D, HB + (size_t)rw_ * D, F.lane); } while (0)
          if (gw + 7 * NGW < ML) {
            P6_LOAD(A0, 0); P6_LOAD(A1, 1); P6_LOAD(B0, 2); P6_LOAD(B1, 3);
            P6_FIN(A0, 0); P6_FIN(A1, 1); P6_LOAD(A0, 4); P6_LOAD(A1, 5);
            P6_FIN(B0, 2); P6_FIN(B1, 3); P6_LOAD(B0, 6); P6_LOAD(B1, 7);
            P6_FIN(A0, 4); P6_FIN(A1, 5); P6_FIN(B0, 6); P6_FIN(B1, 7);
          } else { for (int kk = 0; gw + kk * NGW < ML; ++kk) { P6_LOAD(A0, kk); P6_FIN(A0, kk); } }
#undef P6_LOAD
#undef P6_FIN
        }
    } SEAM(6);
    STAMP(7);
    if (IN(7)) { constexpr int REP_ = (PROBE_PH == 7) ? 2 : 1;
        SchedPlain S; S.o.init(MT / 256, 5632 / 256, F.G, (int)blockIdx.x, REP_); S.A = HB; S.Bt = (const bf16_t*)(ws + WS_WFGU); S.lda = D; S.ldb = D; S.nt = D / 64;
        EpiSwiglu E{(bf16_t*)(ws + WS_HF), LDF, 22, (unsigned)((size_t)MT * LDF * 2)};
        pg8::gemm_phase<EpiSwiglu, SchedPlain, ALIGN17>(F.lds, D, D, D, S, E);
    } SEAM(7);
    STAMP(8);
    if (IN(8)) { constexpr int REP_ = 1;
        SchedCtxSplit S; S.o.init(64, 4, F.G, (int)blockIdx.x, 1); S.A = (const bf16_t*)(ws + WS_HF); S.Bt = (const bf16_t*)(ws + WS_WFD); S.lda = LDF; S.ldb = LDF; S.ntfull = DFF / 64; S.S = 11; S.G = F.G; S.c = (int)blockIdx.x;
        EpiBf16OrPart E{(bf16_t*)(ws + WS_Y2), D, (float*)(ws + WS_PART8), ML, MC};
        pg8::gemm_phase<EpiBf16OrPart, SchedCtxSplit>(F.lds, DFF, LDF, LDF, S, E); (void)REP_;
    } SEAM(8);
    STAMP(9);
    if (IN(9)) RPT(9) {
        const int NGW = F.G * NWAVES; const bf16_t* Y2 = (const bf16_t*)(ws + WS_Y2);
        LAS float* tab = (LAS float*)F.lds;
        load_modtab(F, tab, 0, NB + 1, modp + 5 * 1024, modp + 5 * 6144, modp + 5 * 6144 + 1024, args.in[I_n1g] + D);
        { const int r = F.vcu * NWAVES + F.wave; if (r < MC)
            ctx_row_part(XC + (size_t)r * D, XC + (size_t)r * D, (const float*)(ws + WS_PART8), 11, r, tab + (size_t)NB * 3072, HB + (size_t)(ML + r) * D, F.lane); }
        { const int gw = F.vcu * NWAVES + F.wave; RowRegs A0, A1, B0, B1;
#define P9_LOAD(R, k) load_row<true, true>(R, XB + (size_t)(gw + (k) * NGW) * D, Y2 + (size_t)(gw + (k) * NGW) * D, F.lane)
#define P9_FIN(R, k) do { const int rw_ = gw + (k) * NGW; finish_row<true, true, true>(R, tab + (size_t)(rw_ / SEQ) * 3072, XB + (size_t)rw_ * D, HB + (size_t)rw_ * D, F.lane); } while (0)
          if (gw + 7 * NGW < ML) {
            P9_LOAD(A0, 0); P9_LOAD(A1, 1); P9_LOAD(B0, 2); P9_LOAD(B1, 3);
            P9_FIN(A0, 0); P9_FIN(A1, 1); P9_LOAD(A0, 4); P9_LOAD(A1, 5);
            P9_FIN(B0, 2); P9_FIN(B1, 3); P9_LOAD(B0, 6); P9_LOAD(B1, 7);
            P9_FIN(A0, 4); P9_FIN(A1, 5); P9_FIN(B0, 6); P9_FIN(B1, 7);
          } else { for (int kk = 0; gw + kk * NGW < ML; ++kk) { P9_LOAD(A0, kk); P9_FIN(A0, kk); } }
#undef P9_LOAD
#undef P9_FIN
        }
    } SEAM(9);
    STAMP(10);
    if (IN(10)) { constexpr int REP_ = (PROBE_PH == 10) ? 2 : 1;
        SchedPlain S; S.o.init(MT / 256, D / 256, F.G, (int)blockIdx.x, REP_); S.A = HB; S.Bt = (const bf16_t*)(ws + WS_WS5); S.lda = D; S.ldb = D; S.nt = D / 64;
        EpiS5In E{(bf16_t*)(ws + WS_ACAT), (bf16_t*)(ws + WS_ACATC)};
        pg8::gemm_phase<EpiS5In, SchedPlain>(F.lds, D, D, D, S, E);
        if (F.tailconv && (int)blockIdx.x >= 16 && REP_ == 1) tail_convert(F, TCD, TCE, (int)blockIdx.x - 16, 240);
    } SEAM(10);
    STAMP(11);
    if (IN(11)) { constexpr int REP_ = (PROBE_PH == 11) ? 2 : 1;
        SchedSloc S; S.o.init(64 * 3, 1, F.G, (int)blockIdx.x, REP_); S.acat = (const bf16_t*)(ws + WS_ACAT); S.acatc = (const bf16_t*)(ws + WS_ACATC); S.bhat = (const bf16_t*)(ws + WS_BHAT);
        EpiSloc E{(float*)(ws + WS_SLOC)};
        pg8::gemm_phase<EpiSloc, SchedSloc>(F.lds, SK, SKA, SK, S, E);
#ifndef LT_IN_P11
#define LT_IN_P11 0
#endif
        if (F.tailconv && (int)blockIdx.x >= 192 && REP_ == 1) { if (LT_IN_P11) lt_expand(F, ((int)blockIdx.x - 192) * NWAVES + F.wave, 64 * NWAVES); tail_convert(F, TCE, TCF, (int)blockIdx.x - 192, 64); }
    } SEAM(11);
    STAMP(12);
    if (IN(12)) RPT(12) { p12_scan(F); if (F.tailconv && F.vcu >= 64 && rep_ == 0) { if (!LT_IN_P1 && !LT_IN_P11) lt_expand(F, (F.vcu - 64) * NWAVES + F.wave, 192 * NWAVES); tail_convert(F, TCF, TC_CHUNKS, F.vcu - 64, 192); } } SEAM(12);
    STAMP(13);
    if (IN(13)) { constexpr int REP_ = (PROBE_PH == 13) ? 2 : 1;
        SchedS5Out S; S.o.init(64 * 2, 2, F.G, (int)blockIdx.x, REP_); S.acat = (const bf16_t*)(ws + WS_ACAT); S.lt = (const bf16_t*)(ws + WS_LT);
        EpiS5Out E{(const bf16_t*)(ws + WS_ACAT), args.in[I_odd], (bf16_t*)(ws + WS_GB)};
        pg8::gemm_phase<EpiS5Out, SchedS5Out>(F.lds, SKA, SKA, SKA, S, E);
    } SEAM(13);
    STAMP(14);
    if (IN(14)) { constexpr int REP_ = (PROBE_PH == 14) ? 2 : 1;
        SchedPlain S; S.o.init(ML / 256, 2048 / 256, F.G, (int)blockIdx.x, REP_); S.A = (const bf16_t*)(ws + WS_GB); S.Bt = (const bf16_t*)(ws + WS_WGLU); S.lda = D; S.ldb = D; S.nt = D / 64;
        EpiGlu E{(bf16_t*)(ws + WS_Y3)};
        pg8::gemm_phase<EpiGlu, SchedPlain>(F.lds, D, D, D, S, E);
    } SEAM(14);
    STAMP(15);
    if (IN(15)) RPT(15) { p15_route_gather(F); FSTAMP(F, 102); }
    CKSUM(15); if (IN(15) && IN(17)) xcd_barrier(bar);
    STAMP(17);
    if (IN(17)) { constexpr int REP_ = (PROBE_PH == 17) ? 2 : 1;
        if (!IN(15)) moe_tables(F);
        const LAS int* toff = (const LAS int*)(F.lds + LDS_MOE);
        SchedMoe S; S.o.init(toff[NE], 28, F.G, (int)blockIdx.x, REP_); S.A = (const bf16_t*)(ws + WS_XG); S.W = (const bf16_t*)(ws + WS_WMOE_GU); S.lda = D; S.ldb = D; S.nrows_e = 7168; S.tile_e = toff + 16; S.nt = D / 64;
        EpiSwiglu E{(bf16_t*)(ws + WS_HM), DFE, 28, (unsigned)((size_t)MOE_ROWS * DFE * 2)};
#ifndef STAG17
#define STAG17 0
#endif
        if (STAG17) { const int units = toff[NE] * 28, rem = units % F.G;
            if (rem > 0 && (int)blockIdx.x >= rem) { const int k = ((int)blockIdx.x & 3) + 1; for (int i = 0; i < k * STAG17; ++i) __builtin_amdgcn_s_sleep(127); } }
        pg8::gemm_phase<EpiSwiglu, SchedMoe, ALIGN17>(F.lds, D, D, D, S, E);
    } SEAM(17);
    STAMP(18);
    if (IN(18)) { constexpr int REP_ = (PROBE_PH == 18) ? 2 : 1;
        if (!IN(17)) moe_tables(F);
        const LAS int* toff = (const LAS int*)(F.lds + LDS_MOE);
        const int NT = toff[NE]; int RT, SS; moe_split_plan(NT, F.G, RT, SS);
        SchedMoeD S; S.o.init(RT, 4, F.G, (int)blockIdx.x, 1); S.A = (const bf16_t*)(ws + WS_HM); S.W = (const bf16_t*)(ws + WS_WMOE_D); S.lda = DFE; S.ldb = DFE; S.ntfull = DFE / 64; S.S = SS; S.G = F.G; S.c = (int)blockIdx.x; S.RT = RT; S.NT = NT; S.tile_e = toff + 16;
        EpiBf16OrPart E{(bf16_t*)(ws + WS_XG), D, (float*)(ws + WS_PART18), RT * 256, (NT - RT) * 256};
        pg8::gemm_phase<EpiBf16OrPart, SchedMoeD>(F.lds, DFE, DFE, DFE, S, E); (void)REP_;
    }
    if (TSTAMP >= 0 && blockIdx.x == 0 && F.tid == 0) { if (TSTAMP + TSPAN >= 19) tsl[1] = wall_clock64(); float us = (float)(tsl[1] - tsl[0]) * 0.01f; if (GSEL >= 0) { const unsigned long long* gs_ = (const unsigned long long*)(ws + WS_CTL + CTL_TS + 64); us = (float)(__hip_atomic_load(gs_ + 1, __ATOMIC_RELAXED, __HIP_MEMORY_SCOPE_AGENT) - ~__hip_atomic_load(gs_, __ATOMIC_RELAXED, __HIP_MEMORY_SCOPE_AGENT)) * 0.01f; } ((float*)(ws + WS_CTL + CTL_TS))[0] = 1.f + (us - (float)TSBIAS) * (1.f / (float)TSDIV); }
    SEAM(18);
    STAMP(19);
    if (IN(19)) RPT(19) { if (!IN(18)) moe_tables(F); p19_final(F); }
#undef IN
#undef SEAM
}

inline void launch_range(const Args& base, int lo, int hi, int grid, hipStream_t stream, bool zero_bar) {
    Args a = base; a.ph_lo = lo; a.ph_hi = hi;
    if (zero_bar && hi - lo > 1) (void)hipMemsetAsync(a.ws + WS_CTL + (size_t)CW_BAR * 4, 0, XCD_BAR_WORDS * 4, stream);
    hipLaunchKernelGGL(fwd, dim3(grid), dim3(NTHR), LDS_BYTES, stream, a);
    const hipError_t le = hipPeekAtLastError();
    if (le != hipSuccess) fprintf(stderr, "kernel_launch: launch [%d,%d) failed: %s\n", lo, hi, hipGetErrorName(le));
}
}

#ifndef DBG_MODE
#define DBG_MODE 0
#endif
#ifndef PER_PHASE
#define PER_PHASE 0
#endif
extern "C" void kernel_launch(void* const* d_in, const int* in_sizes, int n_in, void* d_out, int out_size, void* d_ws, size_t ws_size, hipStream_t stream) {
    (void)in_sizes; (void)out_size;
    static int grid = 0;
    if (grid == 0) {
        int dev = 0, cus = 0;
        if (n_in != 33 || ws_size < fp::WS_END || hipGetDevice(&dev) != hipSuccess || hipDeviceGetAttribute(&cus, hipDeviceAttributeMultiprocessorCount, dev) != hipSuccess) { fprintf(stderr, "kernel_launch: bad setup (n_in %d ws %zu)\n", n_in, ws_size); grid = -1; return; }
        if (hipFuncSetAttribute((const void*)fp::fwd, hipFuncAttributeMaxDynamicSharedMemorySize, fp::LDS_BYTES) != hipSuccess) { fprintf(stderr, "kernel_launch: hipFuncSetAttribute failed\n"); grid = -1; return; }
        int per_cu = 0; (void)hipOccupancyMaxActiveBlocksPerMultiprocessor(&per_cu, (const void*)fp::fwd, fp::NTHR, fp::LDS_BYTES); (void)hipGetLastError();
        if (per_cu < 1) fprintf(stderr, "kernel_launch: occupancy query says %d\n", per_cu);
        grid = cus;
    }
    if (grid < 0) return;
    fp::Args a{};
    for (int i = 0; i < 33; ++i) a.in[i] = (const float*)d_in[i];
    a.out = (float*)d_out; a.ws = (unsigned char*)d_ws; a.ph_lo = 0; a.ph_hi = fp::NPH;
    auto run = [&](int lo, int hi) {
#if PER_PHASE
        for (int k = lo; k < hi; ++k) fp::launch_range(a, k, k + 1, grid, stream, false);
#else
        fp::launch_range(a, lo, hi, grid, stream, DBG_MODE != 0);
#endif
    };
    (void)hipMemsetAsync((char*)d_ws + fp::WS_CTL, 0, fp::CTL_BYTES, stream);
    run(0, fp::NPH);
}
```
